# Optimizing an MI355X kernel written in HIP

```python
import jax, jax.numpy as jnp
from jax import lax
import numpy as np

D_MODEL = 1024
BATCH = 4
SEQ = 4096
DEPTH = 4

PLE_DIM = 256
D_MIX = D_MODEL
W_GRP = D_MIX // 4
N_HEADS_GRP = 4
HEAD_DIM = W_GRP // N_HEADS_GRP
GMLP_CHUNK = 128
RGLRU_CONV = 4
RGLRU_C = 8.0
HGRN_CHUNK = 64
POOL_WINDOWS = (2, 4, 8, 16)
D_FF = 2816
FFN_CONV = 3
EPS = 1e-6
COLS_A = 2 * W_GRP
COLS_B = 2 * W_GRP
COLS_C = 4 * W_GRP
COLS_D = W_GRP
OFF_B = COLS_A
OFF_C = OFF_B + COLS_B
OFF_D = OFF_C + COLS_C
D_PROJ = OFF_D + COLS_D

kernel_name = "hymba_style_gmlp_rglru_hgrn2_pool_hybrid"


def rms_norm(x, g):
    xf = x.astype(jnp.float32)
    y = xf * lax.rsqrt(jnp.mean(xf * xf, axis=-1, keepdims=True) + EPS)
    return (y * g.astype(jnp.float32)).astype(x.dtype)


def causal_dwconv(x, w, b):
    k_width = w.shape[0]
    s = x.shape[1]
    xp = jnp.pad(x, ((0, 0), (k_width - 1, 0), (0, 0)))
    y = b
    for k in range(k_width):
        y = y + xp[:, k:k + s] * w[k]
    return y


def gmlp_mixer(ab, ln_g, ln_b, ws, bs):
    bsz, s, _ = ab.shape
    ab = jax.nn.gelu(ab)
    u, v = jnp.split(ab, 2, axis=-1)
    vf = v.astype(jnp.float32)
    mu = jnp.mean(vf, axis=-1, keepdims=True)
    var = jnp.mean(jnp.square(vf - mu), axis=-1, keepdims=True)
    vn = ((vf - mu) * lax.rsqrt(var + EPS) * ln_g.astype(jnp.float32) + ln_b.astype(jnp.float32)).astype(v.dtype)
    vn = vn.reshape(bsz, s // GMLP_CHUNK, GMLP_CHUNK, N_HEADS_GRP, HEAD_DIM)
    mask = jnp.tril(jnp.ones((GMLP_CHUNK, GMLP_CHUNK), dtype=bool))
    wm = jnp.where(mask, ws, jnp.zeros_like(ws))
    sv = jnp.einsum('hts,bnshd->bnthd', wm, vn) + bs.T[:, :, None]
    return u * sv.reshape(bsz, s, W_GRP)


def rglru_mixer(xb, gb, conv_w, conv_b, wa, ba, wx, bx, lam):
    bsz, s, _ = xb.shape
    xc = causal_dwconv(xb, conv_w, conv_b)
    xh = xc.reshape(bsz, s, N_HEADS_GRP, HEAD_DIM)
    r = jax.nn.sigmoid(jnp.einsum('bshd,hde->bshe', xh, wa).reshape(bsz, s, W_GRP) + ba)
    i = jax.nn.sigmoid(jnp.einsum('bshd,hde->bshe', xh, wx).reshape(bsz, s, W_GRP) + bx)
    log_a = -RGLRU_C * r.astype(jnp.float32) * jax.nn.softplus(-lam.astype(jnp.float32))
    a = jnp.exp(log_a)
    mult = jnp.sqrt(-jnp.expm1(2.0 * log_a))
    bterm = mult * (i * xc).astype(jnp.float32)

    def combine(c1, c2):
        a1, b1 = c1
        a2, b2 = c2
        return a1 * a2, a2 * b1 + b2

    _, h = lax.associative_scan(combine, (a, bterm), axis=1)
    return h.astype(xb.dtype) * jax.nn.gelu(gb)


def hgrn2_mixer(q, f, i, g, lb, norm_g):
    bsz, s, _ = q.shape
    n_chunks = s // HGRN_CHUNK
    qf = jax.nn.silu(q.astype(jnp.float32))
    fgate = lb + (1.0 - lb) * jax.nn.sigmoid(f.astype(jnp.float32))
    log_f = jnp.log(fgate)
    kf = 1.0 - fgate
    vf = i.astype(jnp.float32)

    def to_chunks(t):
        return t.reshape(bsz, n_chunks, HGRN_CHUNK, N_HEADS_GRP, HEAD_DIM).transpose(1, 0, 3, 2, 4)

    qc, kc, vc = to_chunks(qf), to_chunks(kf), to_chunks(vf)
    bc = jnp.cumsum(to_chunks(log_f), axis=3)
    mask = jnp.tril(jnp.ones((HGRN_CHUNK, HGRN_CHUNK), dtype=bool))[:, :, None]

    def step(state, xs):
        qq, kk, vv, bb = xs
        diff = bb[:, :, :, None, :] - bb[:, :, None, :, :]
        decay = jnp.exp(jnp.where(mask, diff, -jnp.inf))
        att = jnp.einsum('bhtd,bhsd,bhtsd->bhts', qq, kk, decay)
        o = jnp.einsum('bhts,bhsv->bhtv', att, vv) + jnp.einsum('bhtd,bhdv->bhtv', qq * jnp.exp(bb), state)
        bl = bb[:, :, -1:, :]
        new_state = jnp.exp(bl[:, :, 0, :])[..., None] * state + jnp.einsum('bhsd,bhsv->bhdv', kk * jnp.exp(bl - bb), vv)
        return new_state, o

    s0 = jnp.zeros((bsz, N_HEADS_GRP, HEAD_DIM, HEAD_DIM), jnp.float32)
    _, o = lax.scan(step, s0, (qc, kc, vc, bc))
    o = o.transpose(1, 0, 3, 2, 4).reshape(bsz, s, N_HEADS_GRP, HEAD_DIM)
    o = o * lax.rsqrt(jnp.mean(o * o, axis=-1, keepdims=True) + EPS) * norm_g.astype(jnp.float32)
    o = o.reshape(bsz, s, W_GRP) * jax.nn.silu(g.astype(jnp.float32))
    return o.astype(q.dtype)


def pool_mixer(xd, wd, scale):
    bsz, s, _ = xd.shape
    xf = xd.astype(jnp.float32)
    cs = jnp.cumsum(xf, axis=1)
    pos = jnp.arange(1, s + 1, dtype=jnp.float32)[None, :, None]
    outs = []
    for j, w in enumerate(POOL_WINDOWS):
        c = cs[..., j * HEAD_DIM:(j + 1) * HEAD_DIM]
        shifted = jnp.pad(c, ((0, 0), (w, 0), (0, 0)))[:, :s]
        mean = (c - shifted) / jnp.minimum(pos, float(w))
        outs.append(mean - xf[..., j * HEAD_DIM:(j + 1) * HEAD_DIM])
    pooled = jnp.stack(outs, axis=2)
    y = jnp.einsum('bsgd,gde->bsge', pooled, wd.astype(jnp.float32)).reshape(bsz, s, W_GRP)
    return (y * scale.astype(jnp.float32)).astype(xd.dtype)


def setup_inputs(seed: int = 0) -> dict:
    key = jax.random.key(seed)
    ks = jax.random.split(key, 32)

    def nrm(k, shape, scale):
        return jax.random.normal(k, shape, jnp.float32) * scale

    u = jax.random.uniform(ks[14], (DEPTH, W_GRP), jnp.float32, 0.9, 0.999)
    a_base = u ** (1.0 / RGLRU_C)
    b_lam = jnp.log(a_base) - jnp.log1p(-a_base)
    return {
        "x": nrm(ks[0], (BATCH, SEQ, D_MODEL), 1.0),
        "p": nrm(ks[1], (DEPTH, BATCH, SEQ, PLE_DIM), 1.0),
        "norm1_g": 1.0 + nrm(ks[2], (DEPTH, D_MODEL), 0.02),
        "w_in": nrm(ks[3], (DEPTH, D_MODEL, D_PROJ), D_MODEL ** -0.5),
        "a_ln_g": 1.0 + nrm(ks[4], (DEPTH, W_GRP), 0.02),
        "a_ln_b": nrm(ks[5], (DEPTH, W_GRP), 0.02),
        "a_ws": nrm(ks[6], (DEPTH, N_HEADS_GRP, GMLP_CHUNK, GMLP_CHUNK), GMLP_CHUNK ** -0.5),
        "a_bs": 1.0 + nrm(ks[7], (DEPTH, N_HEADS_GRP, GMLP_CHUNK), 0.1),
        "b_conv_w": nrm(ks[8], (DEPTH, RGLRU_CONV, W_GRP), RGLRU_CONV ** -0.5),
        "b_conv_b": nrm(ks[9], (DEPTH, W_GRP), 0.02),
        "b_wa": nrm(ks[10], (DEPTH, N_HEADS_GRP, HEAD_DIM, HEAD_DIM), HEAD_DIM ** -0.5),
        "b_ba": nrm(ks[11], (DEPTH, W_GRP), 0.02),
        "b_wx": nrm(ks[12], (DEPTH, N_HEADS_GRP, HEAD_DIM, HEAD_DIM), HEAD_DIM ** -0.5),
        "b_bx": nrm(ks[13], (DEPTH, W_GRP), 0.02),
        "b_lam": b_lam,
        "c_lb": nrm(ks[15], (DEPTH, W_GRP), 0.5),
        "c_norm_g": 1.0 + nrm(ks[16], (DEPTH, HEAD_DIM), 0.02),
        "d_w": nrm(ks[17], (DEPTH, N_HEADS_GRP, HEAD_DIM, HEAD_DIM), HEAD_DIM ** -0.5),
        "d_scale": 1.0 + nrm(ks[18], (DEPTH, W_GRP), 0.1),
        "w_out": nrm(ks[19], (DEPTH, D_MIX, D_MODEL), D_MIX ** -0.5),
        "norm2_g": 1.0 + nrm(ks[20], (DEPTH, D_MODEL), 0.02),
        "w_up": nrm(ks[21], (DEPTH, D_MODEL, 2 * D_FF), D_MODEL ** -0.5),
        "ffn_conv_w": nrm(ks[22], (DEPTH, FFN_CONV, 2 * D_FF), FFN_CONV ** -0.5),
        "ffn_conv_b": nrm(ks[23], (DEPTH, 2 * D_FF), 0.02),
        "w_down": nrm(ks[24], (DEPTH, D_FF, D_MODEL), D_FF ** -0.5),
        "norm3_g": 1.0 + nrm(ks[25], (DEPTH, D_MODEL), 0.02),
        "w_pe": nrm(ks[26], (DEPTH, PLE_DIM, D_MODEL), PLE_DIM ** -0.5),
        "w_pg": nrm(ks[27], (DEPTH, D_MODEL, D_MODEL), D_MODEL ** -0.5),
        "final_g": 1.0 + nrm(ks[28], (D_MODEL,), 0.02),
    }


def reference(x, p, norm1_g, w_in, a_ln_g, a_ln_b, a_ws, a_bs, b_conv_w, b_conv_b, b_wa, b_ba, b_wx, b_bx, b_lam, c_lb, c_norm_g, d_w, d_scale, w_out, norm2_g, w_up, ffn_conv_w, ffn_conv_b, w_down, norm3_g, w_pe, w_pg, final_g):
    lbs = jnp.cumsum(jax.nn.softmax(c_lb.astype(jnp.float32), axis=0), axis=0)
    lbs = lbs - lbs[0:1]
    for l in range(DEPTH):
        h = rms_norm(x, norm1_g[l])
        z = h @ w_in[l]
        y_a = gmlp_mixer(z[..., :OFF_B], a_ln_g[l], a_ln_b[l], a_ws[l], a_bs[l])
        y_b = rglru_mixer(z[..., OFF_B:OFF_B + W_GRP], z[..., OFF_B + W_GRP:OFF_C],
                          b_conv_w[l], b_conv_b[l], b_wa[l], b_ba[l], b_wx[l], b_bx[l], b_lam[l])
        zc = z[..., OFF_C:OFF_D]
        y_c = hgrn2_mixer(zc[..., :W_GRP], zc[..., W_GRP:2 * W_GRP], zc[..., 2 * W_GRP:3 * W_GRP],
                          zc[..., 3 * W_GRP:], lbs[l], c_norm_g[l])
        y_d = pool_mixer(z[..., OFF_D:], d_w[l], d_scale[l])
        mix = jnp.concatenate([y_a, y_b, y_c, y_d], axis=-1)
        x = x + mix @ w_out[l]
        hf = rms_norm(x, norm2_g[l]) @ w_up[l]
        hf = causal_dwconv(hf, ffn_conv_w[l], ffn_conv_b[l])
        gt, val = jnp.split(hf, 2, axis=-1)
        x = x + (jax.nn.gelu(gt) * val) @ w_down[l]
        gate = jax.nn.sigmoid(rms_norm(x, norm3_g[l]) @ w_pg[l])
        x = x + (p[l] @ w_pe[l]) * gate
    return rms_norm(x, final_g)
```

```cpp
#include <hip/hip_runtime.h>
#include <hip/hip_cooperative_groups.h>
#include <cstdio>
#include <cstdint>
namespace cg = cooperative_groups;
#ifndef REP_SYNC
#define REP_SYNC 0
#endif
#ifndef REP_UP
#define REP_UP 1
#endif
#ifndef REP_MIX
#define REP_MIX 1
#endif
#ifndef REP_ELT
#define REP_ELT 1
#endif
namespace pg8 {
#define PG8_LAS __attribute__((address_space(3)))
typedef unsigned short bf16_t;
typedef short bf16x8 __attribute__((ext_vector_type(8)));
typedef float f32x4 __attribute__((ext_vector_type(4)));
typedef unsigned u32x4 __attribute__((ext_vector_type(4)));
constexpr int BM = 256, BK = 64, HALF = 128, HTB = HALF * BK * 2  , STAGE_BYTES = 8 * HTB, NXCD = 8, WGM = 8;
__host__ __device__ __forceinline__ int lds_byte(int r, int c) { const int st = (r >> 4) * 2 + (c >> 5), rr = r & 15, cc = c & 31, ob = rr * 64 + cc * 2; return st * 1024 + (ob ^ (((ob >> 9) & 1) << 5)); }
__host__ __device__ __forceinline__ void stage_rc(int b, int& R, int& C) { const int st = b / 1024, sb = b % 1024, swz = sb ^ (((sb >> 9) & 1) << 5); R = (st >> 1) * 16 + swz / 64; C = (st & 1) * 32 + (swz % 64) / 2; }
__host__ __device__ __forceinline__ int perm32(int rho) { const int n = rho >> 4, i = rho & 15; return 8 * (i >> 2) + 4 * n + (i & 3); }
struct Unit { int pm, pn; };
struct Gemm { const bf16_t* A; const bf16_t* Bt; int M, N, K; int conv; };
__host__ __device__ __forceinline__ long conv_rowbase(int pm) { return (long)(pm / 17) * 4096 + 254 * (pm % 17) - 2; }
struct StaticOrder {
    int nM, nN, nwg, G, c;
    __host__ __device__ void init(int M, int N, int G_, int c_) { nM = M / BM; nN = N / BM; nwg = nM * nN; G = G_; c = c_; }
    __host__ __device__ bool next(int i, Unit& u) const {
        const long L = (long)i * G + c; if (L >= nwg) return false;
        int wgid = (int)L; { const int q = nwg / NXCD, r = nwg % NXCD, xcd = wgid % NXCD, off = wgid / NXCD; wgid = (xcd < r ? xcd * (q + 1) : r * (q + 1) + (xcd - r) * q) + off; }
        const int nig = WGM * nN, gid = wgid / nig, fm = gid * WGM, gsz = (nM - fm) < WGM ? (nM - fm) : WGM;
        u.pm = fm + ((wgid % nig) % gsz); u.pn = (wgid % nig) / gsz; return true;
    }
    __device__ __forceinline__ void a_ready(const Unit&) const {}
    __device__ __forceinline__ void done(const Unit&) const {}
};
__device__ __forceinline__ unsigned cvt_pk_bf16(float lo, float hi) { unsigned r; asm volatile("v_cvt_pk_bf16_f32 %0, %1, %2" : "=v"(r) : "v"(lo), "v"(hi)); return r; }
__device__ __forceinline__ float bf_lo(unsigned w) { return __uint_as_float(w << 16); }
__device__ __forceinline__ float bf_hi(unsigned w) { return __uint_as_float(w & 0xffff0000u); }
template <int mode> struct Epi {
    static constexpr bool PERM = true, AFTER_DRAIN = false;
    bf16_t* O; int ldc; const bf16_t* XBi; const bf16_t* PE; const float* SSin; float* SSout; bf16_t* XBo;
    const float* cw; const float* cb; PG8_LAS float* exch;
    __device__ __forceinline__ void operator()(f32x4 (&acc)[2][2][4][2], const Unit& u, int wr, int wc, int fr, int fq) const {
        if constexpr (mode == 3) { conv_epi(acc, u, wr, wc, fr, fq); return; }
        const int row0 = u.pm * BM + wr * 64 + fr, col0 = u.pn * BM + wc * 32 + 8 * fq;
        float rsv[2][4];
        if (mode != 1 && SSin) { f32x4 p4[2][4];
#pragma unroll
            for (int ai = 0; ai < 2; ++ai)
#pragma unroll
                for (int m = 0; m < 4; ++m) p4[ai][m] = *(const f32x4*)(SSin + (size_t)(row0 + ai * HALF + m * 16) * 16 + 4 * fq);
            __builtin_amdgcn_sched_barrier(0);
#pragma unroll
            for (int ai = 0; ai < 2; ++ai)
#pragma unroll
                for (int m = 0; m < 4; ++m) { float t = (p4[ai][m][0] + p4[ai][m][1]) + (p4[ai][m][2] + p4[ai][m][3]); t += __shfl_xor(t, 16); t += __shfl_xor(t, 32); rsv[ai][m] = rsqrtf(t * (1.f / 1024.f) + 1e-6f); }
        } else {
#pragma unroll
            for (int ai = 0; ai < 2; ++ai)
#pragma unroll
                for (int m = 0; m < 4; ++m) rsv[ai][m] = 1.f;
        }
        if (mode == 0) {
#pragma unroll
            for (int ai = 0; ai < 2; ++ai)
#pragma unroll
                for (int m = 0; m < 4; ++m) { const float rs = rsv[ai][m]; bf16_t* rowp = O + (size_t)(row0 + ai * HALF + m * 16) * ldc + col0;
#pragma unroll
                    for (int bj = 0; bj < 2; ++bj) { const f32x4 v0 = acc[ai][bj][m][0] * rs, v1 = acc[ai][bj][m][1] * rs;
                        u32x4 w; w.x = cvt_pk_bf16(v0[0], v0[1]); w.y = cvt_pk_bf16(v0[2], v0[3]); w.z = cvt_pk_bf16(v1[0], v1[1]); w.w = cvt_pk_bf16(v1[2], v1[3]);
                        *(u32x4*)(rowp + bj * HALF) = w; } }
        } else {
#pragma unroll
            for (int ab = 0; ab < 4; ++ab) { const int ai = ab >> 1, mb = (ab & 1) * 2;
                u32x4 xi[2][2], pe[2][2];
#pragma unroll
                for (int mm = 0; mm < 2; ++mm)
#pragma unroll
                    for (int bj = 0; bj < 2; ++bj) { const size_t off = (size_t)(row0 + ai * HALF + (mb + mm) * 16) * 1024 + col0 + bj * HALF;
                        xi[mm][bj] = *(const u32x4*)(XBi + off); if (mode == 2) pe[mm][bj] = *(const u32x4*)(PE + off); }
                __builtin_amdgcn_sched_barrier(0);
#pragma unroll
                for (int mm = 0; mm < 2; ++mm) { const int m = mb + mm; const int row = row0 + ai * HALF + m * 16; const size_t off = (size_t)row * 1024 + col0; const float rs = rsv[ai][m]; float ss = 0.f;
#pragma unroll
                    for (int bj = 0; bj < 2; ++bj) { const u32x4 x4 = xi[mm][bj];
                        const f32x4 a = {bf_lo(x4.x), bf_hi(x4.x), bf_lo(x4.y), bf_hi(x4.y)}, b = {bf_lo(x4.z), bf_hi(x4.z), bf_lo(x4.w), bf_hi(x4.w)}; f32x4 x0, x1;
                        if (mode == 1) { x0 = a + acc[ai][bj][m][0]; x1 = b + acc[ai][bj][m][1]; }
                        else { const u32x4 p4 = pe[mm][bj]; const f32x4 v0 = acc[ai][bj][m][0] * rs, v1 = acc[ai][bj][m][1] * rs; f32x4 s0, s1;
#pragma unroll
                            for (int j = 0; j < 4; ++j) { s0[j] = __builtin_amdgcn_rcpf(1.f + __builtin_amdgcn_exp2f(-1.4426950408889634f * v0[j])); s1[j] = __builtin_amdgcn_rcpf(1.f + __builtin_amdgcn_exp2f(-1.4426950408889634f * v1[j])); }
                            const f32x4 e0 = {bf_lo(p4.x), bf_hi(p4.x), bf_lo(p4.y), bf_hi(p4.y)}, e1 = {bf_lo(p4.z), bf_hi(p4.z), bf_lo(p4.w), bf_hi(p4.w)};
                            x0 = a + e0 * s0; x1 = b + e1 * s1; }
                        u32x4 w; w.x = cvt_pk_bf16(x0[0], x0[1]); w.y = cvt_pk_bf16(x0[2], x0[3]); w.z = cvt_pk_bf16(x1[0], x1[1]); w.w = cvt_pk_bf16(x1[2], x1[3]);
                        *(u32x4*)(XBo + off + bj * HALF) = w;
                        ss += (x0[0] * x0[0] + x0[1] * x0[1]) + (x0[2] * x0[2] + x0[3] * x0[3]) + (x1[0] * x1[0] + x1[1] * x1[1]) + (x1[2] * x1[2] + x1[3] * x1[3]); }
                    ss += __shfl_xor(ss, 16); ss += __shfl_xor(ss, 32);
                    if (fq == 0) SSout[(size_t)row * 16 + u.pn * 4 + wc] = ss;
                }
            }
        }
    }

    static __device__ __forceinline__ float dpp_shr1(float oldv, float src) { return __int_as_float(__builtin_amdgcn_update_dpp(__float_as_int(oldv), __float_as_int(src), 0x111, 0xf, 0xf, false)); }
    static __device__ __forceinline__ float dpp_shr2(float oldv, float src) { return __int_as_float(__builtin_amdgcn_update_dpp(__float_as_int(oldv), __float_as_int(src), 0x112, 0xf, 0xf, false)); }
    static __device__ __forceinline__ float dpp_ror1(float src) { return __int_as_float(__builtin_amdgcn_update_dpp(0, __float_as_int(src), 0x121, 0xf, 0xf, false)); }
    static __device__ __forceinline__ float dpp_ror2(float src) { return __int_as_float(__builtin_amdgcn_update_dpp(0, __float_as_int(src), 0x122, 0xf, 0xf, false)); }
    __device__ __forceinline__ void conv_epi(f32x4 (&acc)[2][2][4][2], const Unit& u, int wr, int wc, int fr, int fq) const {
        const int bq = u.pm / 17, jt = u.pm % 17, tp0 = 254 * jt - 2 + wr * 64 + 4 * fr;
        const int wave = wr * 4 + wc;
        PG8_LAS float* wl = exch + 2048;
        { typedef float f32x2e __attribute__((ext_vector_type(2))); const int idx = (wave * 64 + fq * 16 + fr) * 2, kind = idx >> 7, ch = idx & 127;
          const float* src = ((kind & 3) < 3 ? cw + (kind & 3) * 5632 : cb) + (kind >> 2) * 2816 + u.pn * 128 + ch;
          *(PG8_LAS f32x2e*)(wl + idx) = *(const f32x2e*)src; }
        f32x4 pq[2][4];
#pragma unroll
        for (int ai = 0; ai < 2; ++ai)
#pragma unroll
            for (int m = 0; m < 4; ++m) pq[ai][m] = *(const f32x4*)(SSin + ((long)bq * 4096 + tp0 + ai * HALF + m) * 16 + 4 * fq);
        __builtin_amdgcn_sched_barrier(0);
#pragma unroll
        for (int ai = 0; ai < 2; ++ai)
#pragma unroll
            for (int m = 0; m < 4; ++m) { const int tp = tp0 + ai * HALF + m;
                const f32x4 p4 = pq[ai][m]; float t = (p4[0] + p4[1]) + (p4[2] + p4[3]); t += __shfl_xor(t, 16); t += __shfl_xor(t, 32);
                const float rs = rsqrtf(t * (1.f / 1024.f) + 1e-6f);
                if (ai == 0 && m < 2 && jt == 0 && wr == 0) {
#pragma unroll
                    for (int bj = 0; bj < 2; ++bj)
#pragma unroll
                        for (int n = 0; n < 2; ++n)
#pragma unroll
                            for (int j = 0; j < 4; ++j) acc[ai][bj][m][n][j] = (tp >= 0) ? acc[ai][bj][m][n][j] * rs : 0.f;
                } else {
#pragma unroll
                    for (int bj = 0; bj < 2; ++bj) { acc[ai][bj][m][0] *= rs; acc[ai][bj][m][1] *= rs; }
                } }
        if (fr == 15) {
#pragma unroll
            for (int ai = 0; ai < 2; ++ai)
#pragma unroll
                for (int bj = 0; bj < 2; ++bj)
#pragma unroll
                    for (int n = 0; n < 2; ++n)
#pragma unroll
                        for (int j = 0; j < 4; ++j) { typedef float f32x2e __attribute__((ext_vector_type(2)));
                            *(PG8_LAS f32x2e*)(exch + ((wave * 2 + ai) * 16 + bj * 8 + n * 4 + j) * 8 + fq * 2) = (f32x2e){acc[ai][bj][2][n][j], acc[ai][bj][3][n][j]}; }
        }
        asm volatile("s_waitcnt lgkmcnt(0)" ::: "memory"); __builtin_amdgcn_s_barrier(); asm volatile("" ::: "memory");
        const int cch = u.pn * 128 + wc * 32 + 8 * fq;
#pragma unroll
        for (int ai = 0; ai < 2; ++ai) {
            const bool has_prev = (wr == 1) || (ai == 1);
            const int pw = (wr == 1 ? 0 : 4) + wc, pai = (wr == 1) ? ai : 0;
            unsigned ow[4][4];
#pragma unroll
            for (int n = 0; n < 2; ++n)
#pragma unroll
                for (int jp = 0; jp < 2; ++jp) {
                    float o[4][2];
#pragma unroll
                    for (int jj = 0; jj < 2; ++jj) {
                        const int j = 2 * jp + jj; const PG8_LAS float* wc_ = wl + wc * 32 + 8 * fq + 4 * n + j;
                        const float wg0 = wc_[0], wg1 = wc_[128], wg2 = wc_[256], bg = wc_[384], wv0 = wc_[512], wv1 = wc_[640], wv2 = wc_[768], bv = wc_[896];
                        float pg2 = 0.f, pg3 = 0.f, pv2 = 0.f, pv3 = 0.f;
                        if (has_prev) { typedef float f32x2e __attribute__((ext_vector_type(2)));
                            const f32x2e a = *(const PG8_LAS f32x2e*)(exch + ((pw * 2 + pai) * 16 + n * 4 + j) * 8 + fq * 2), b = *(const PG8_LAS f32x2e*)(exch + ((pw * 2 + pai) * 16 + 8 + n * 4 + j) * 8 + fq * 2);
                            pg2 = a.x; pg3 = a.y; pv2 = b.x; pv3 = b.y; }
                        const float G0 = acc[ai][0][0][n][j], G1 = acc[ai][0][1][n][j], G2 = acc[ai][0][2][n][j], G3 = acc[ai][0][3][n][j];
                        const float V0 = acc[ai][1][0][n][j], V1 = acc[ai][1][1][n][j], V2 = acc[ai][1][2][n][j], V3 = acc[ai][1][3][n][j];
                        const float Gm1 = dpp_shr1(pg3, G3), Gm2 = dpp_shr1(pg2, G2), Vm1 = dpp_shr1(pv3, V3), Vm2 = dpp_shr1(pv2, V2);
                        const float cg[4] = {bg + wg0 * Gm2 + wg1 * Gm1 + wg2 * G0, bg + wg0 * Gm1 + wg1 * G0 + wg2 * G1, bg + wg0 * G0 + wg1 * G1 + wg2 * G2, bg + wg0 * G1 + wg1 * G2 + wg2 * G3};
                        const float cv[4] = {bv + wv0 * Vm2 + wv1 * Vm1 + wv2 * V0, bv + wv0 * Vm1 + wv1 * V0 + wv2 * V1, bv + wv0 * V0 + wv1 * V1 + wv2 * V2, bv + wv0 * V1 + wv1 * V2 + wv2 * V3};
#pragma unroll
                        for (int m = 0; m < 4; ++m) { o[m][jj] = cg[m] * __builtin_amdgcn_rcpf(1.f + __builtin_amdgcn_exp2f(cg[m] * (-2.3022081980f + -0.1029432398f * (cg[m] * cg[m])))) * cv[m]; }
                    }
#pragma unroll
                    for (int m = 0; m < 4; ++m) ow[m][2 * n + jp] = cvt_pk_bf16(o[m][0], o[m][1]);
                    asm volatile("" ::: "memory");
                }
#pragma unroll
            for (int m = 0; m < 4; ++m) { const int r = ai * HALF + wr * 64 + 4 * fr + m, tp = tp0 + ai * HALF + m;
                if (r >= 2 && tp < 4096) { u32x4 w; w.x = ow[m][0]; w.y = ow[m][1]; w.z = ow[m][2]; w.w = ow[m][3]; *(u32x4*)(O + ((size_t)bq * 4096 + tp) * 2816 + cch) = w; } }
        }
    }

};
template <class Epi, class Sched, bool ALIGN_EPI = false, bool SP2 = false>
__device__ __forceinline__ void gemm_phase(PG8_LAS unsigned char* lds, const Gemm g, const Sched& S, const Epi& E) {
    int tid_ = threadIdx.x; asm volatile("" : "+v"(tid_)); const int tid = tid_, wid = __builtin_amdgcn_readfirstlane(tid >> 6), lane = tid & 63, wr = wid >> 2, wc = wid & 3, fr = lane & 15, fq = lane >> 4;
    const int K = g.K, nt = K / BK;
    unsigned voffA[2], voffB[2];
#pragma unroll
    for (int i = 0; i < 2; ++i) { int R, C; stage_rc(tid * 16 + i * 8192, R, C); const int Rb = Epi::PERM ? ((R & ~31) + perm32(R & 31)) : R;
        const int Ra = g.conv ? ((R & ~63) + 4 * (R & 15) + ((R >> 4) & 3)) : R;
        voffA[i] = (unsigned)(Ra * K + C) * 2u; voffB[i] = (unsigned)(Rb * K + C) * 2u; }
    const size_t kstep = (size_t)(BK * 2);
    const size_t hstep = (size_t)HALF * K * 2;
    const size_t tstep = 2 * hstep;
    const unsigned ldsw = (unsigned)wid * 1024u;
    const int aoff = lds_byte(wr * 64 + fr, fq * 8), boff = lds_byte(wc * 32 + fr, fq * 8);
#define PG8_SA(b, h) (((b) * 2 + (h)) * HTB)
#define PG8_SB(b, h) ((4 + (b) * 2 + (h)) * HTB)
#define PG8_STAGE(bufoff, gbase, voff) do { _Pragma("unroll") for (int _i = 0; _i < 2; ++_i) \
        __builtin_amdgcn_global_load_lds((const unsigned*)((const char*)(gbase) + (voff)[_i]), (PG8_LAS unsigned*)(lds + (bufoff) + ldsw + _i * 8192), 16, 0, 0); } while (0)
#define PG8_LDA(dst, b, h) do { _Pragma("unroll") for (int m = 0; m < 4; ++m) _Pragma("unroll") for (int k = 0; k < 2; ++k) dst[m][k] = *(const PG8_LAS bf16x8*)(lds + PG8_SA(b, h) + aoff + m * 2048 + k * 1024); } while (0)
#define PG8_LDB(dst, b, h) do { _Pragma("unroll") for (int n = 0; n < 2; ++n) _Pragma("unroll") for (int k = 0; k < 2; ++k) dst[n][k] = *(const PG8_LAS bf16x8*)(lds + PG8_SB(b, h) + boff + n * 2048 + k * 1024); } while (0)
#define PG8_MMA(ai, bj, At, Bt) do { __builtin_amdgcn_s_setprio(1); _Pragma("unroll") for (int m = 0; m < 4; ++m) _Pragma("unroll") for (int n = 0; n < 2; ++n) _Pragma("unroll") for (int k = 0; k < 2; ++k) \
        acc[ai][bj][m][n] = __builtin_amdgcn_mfma_f32_16x16x32_bf16(Bt[n][k], At[m][k], acc[ai][bj][m][n], 0, 0, 0); __builtin_amdgcn_s_setprio(0); } while (0)
#define PG8_WAIT_V(n) asm volatile("s_waitcnt vmcnt(" #n ")" ::: "memory")
#define PG8_WAIT_L(n) asm volatile("s_waitcnt lgkmcnt(" #n ")" ::: "memory")
#define PG8_BAR __builtin_amdgcn_s_barrier()
#define PG8_SCHED __builtin_amdgcn_sched_barrier(0)
    Unit cur, nxt; int ui = 0;
    if (!S.next(0, cur)) return;
    f32x4 acc[2][2][4][2];
#pragma unroll
    for (int a = 0; a < 2; ++a)
#pragma unroll
        for (int b = 0; b < 2; ++b)
#pragma unroll
            for (int m = 0; m < 4; ++m)
#pragma unroll
                for (int n = 0; n < 2; ++n) acc[a][b][m][n] = (f32x4){0.f, 0.f, 0.f, 0.f};
    bf16x8 At[4][2], B0[2][2], B1[2][2];
    const char* cA = (const char*)g.A + (g.conv ? (size_t)(conv_rowbase(cur.pm) * (long)(K * 2)) : (size_t)cur.pm * tstep); const char* cB = (const char*)g.Bt + (size_t)cur.pn * tstep;
    S.a_ready(cur);
    if constexpr (SP2) {
        PG8_STAGE(PG8_SB(0, 0), cB, voffB); PG8_STAGE(PG8_SB(0, 1), cB + hstep, voffB); PG8_STAGE(PG8_SA(0, 0), cA, voffA); PG8_STAGE(PG8_SA(0, 1), cA + hstep, voffA);
        if (wr == 1) PG8_BAR;
        PG8_WAIT_V(2); PG8_BAR;
        PG8_STAGE(PG8_SB(1, 0), cB + kstep, voffB); PG8_STAGE(PG8_SA(1, 0), cA + kstep, voffA); PG8_STAGE(PG8_SB(1, 1), cB + hstep + kstep, voffB);
        PG8_WAIT_V(6); PG8_BAR;
    } else {
        PG8_STAGE(PG8_SB(0, 0), cB, voffB); PG8_STAGE(PG8_SA(0, 0), cA, voffA); PG8_STAGE(PG8_SB(0, 1), cB + hstep, voffB); PG8_STAGE(PG8_SA(0, 1), cA + hstep, voffA);
        if (wr == 1) PG8_BAR;
        PG8_WAIT_V(4); PG8_BAR;
        PG8_STAGE(PG8_SB(1, 0), cB + kstep, voffB); PG8_STAGE(PG8_SA(1, 0), cA + kstep, voffA); PG8_STAGE(PG8_SB(1, 1), cB + hstep + kstep, voffB);
        PG8_WAIT_V(6); PG8_BAR;
    }
    for (;;) {
        const bool has_next = S.next(ui + 1, nxt);
        const char* nA = has_next ? (const char*)g.A + (g.conv ? (size_t)(conv_rowbase(nxt.pm) * (long)(K * 2)) : (size_t)nxt.pm * tstep) : cA; const char* nB = has_next ? (const char*)g.Bt + (size_t)nxt.pn * tstep : cB;
        for (int t = 0; t < nt; t += 2) {
            const bool last = (t == nt - 2);
            const char* a1 = cA + (size_t)(t + 1) * kstep;
            const char* a2 = last ? nA : cA + (size_t)(t + 2) * kstep; const char* b2 = last ? nB : cB + (size_t)(t + 2) * kstep;
            const char* a3 = a2 + kstep; const char* b3 = b2 + kstep;
            if (last && has_next) S.a_ready(nxt);
            if constexpr (SP2) {
            PG8_LDB(B0, 0, 0); PG8_LDB(B1, 0, 1); PG8_SCHED; PG8_LDA(At, 0, 0); PG8_STAGE(PG8_SA(1, 1), a1 + hstep, voffA);
            PG8_WAIT_V(8); PG8_WAIT_L(0); PG8_BAR; PG8_MMA(0, 0, At, B0); PG8_MMA(0, 1, At, B1); PG8_BAR; PG8_SCHED;
            PG8_LDA(At, 0, 1); PG8_STAGE(PG8_SB(0, 0), b2, voffB); PG8_STAGE(PG8_SB(0, 1), b2 + hstep, voffB); PG8_STAGE(PG8_SA(0, 0), a2, voffA);
            PG8_WAIT_V(8); PG8_WAIT_L(0); PG8_BAR; PG8_MMA(1, 0, At, B0); PG8_MMA(1, 1, At, B1); PG8_BAR; PG8_SCHED;
            PG8_LDB(B0, 1, 0); PG8_LDB(B1, 1, 1); PG8_SCHED; PG8_LDA(At, 1, 0); PG8_STAGE(PG8_SA(0, 1), a2 + hstep, voffA);
            PG8_WAIT_V(8); PG8_WAIT_L(0); PG8_BAR; PG8_MMA(0, 0, At, B0); PG8_MMA(0, 1, At, B1); PG8_BAR; PG8_SCHED;
            PG8_LDA(At, 1, 1); PG8_STAGE(PG8_SB(1, 0), b3, voffB); PG8_STAGE(PG8_SB(1, 1), b3 + hstep, voffB); PG8_STAGE(PG8_SA(1, 0), a3, voffA);
            PG8_WAIT_V(8); PG8_WAIT_L(0); PG8_BAR; PG8_MMA(1, 0, At, B0); PG8_MMA(1, 1, At, B1); PG8_BAR; PG8_SCHED;
            } else {
            PG8_LDB(B0, 0, 0); PG8_SCHED; PG8_LDA(At, 0, 0); PG8_STAGE(PG8_SA(1, 1), a1 + hstep, voffA);
            PG8_WAIT_L(8); PG8_BAR; PG8_WAIT_L(0); PG8_MMA(0, 0, At, B0); PG8_BAR; PG8_SCHED;
            PG8_LDB(B1, 0, 1); PG8_STAGE(PG8_SB(0, 0), b2, voffB);
            PG8_BAR; PG8_WAIT_L(0); PG8_MMA(0, 1, At, B1); PG8_BAR;
            PG8_LDA(At, 0, 1); PG8_STAGE(PG8_SA(0, 0), a2, voffA);
            PG8_BAR; PG8_WAIT_L(0); PG8_MMA(1, 0, At, B0); PG8_BAR; PG8_SCHED;
            PG8_STAGE(PG8_SB(0, 1), b2 + hstep, voffB);
            PG8_WAIT_V(6); PG8_BAR; PG8_MMA(1, 1, At, B1); PG8_BAR;
            PG8_LDB(B0, 1, 0); PG8_SCHED; PG8_LDA(At, 1, 0); PG8_STAGE(PG8_SA(0, 1), a2 + hstep, voffA);
            PG8_WAIT_L(8); PG8_BAR; PG8_WAIT_L(0); PG8_MMA(0, 0, At, B0); PG8_BAR; PG8_SCHED;
            PG8_LDB(B1, 1, 1); PG8_STAGE(PG8_SB(1, 0), b3, voffB);
            PG8_BAR; PG8_WAIT_L(0); PG8_MMA(0, 1, At, B1); PG8_BAR;
            PG8_LDA(At, 1, 1); PG8_STAGE(PG8_SA(1, 0), a3, voffA);
            PG8_BAR; PG8_WAIT_L(0); PG8_MMA(1, 0, At, B0); PG8_BAR; PG8_SCHED;
            PG8_STAGE(PG8_SB(1, 1), b3 + hstep, voffB);
            PG8_WAIT_V(6); PG8_BAR; PG8_MMA(1, 1, At, B1); PG8_BAR;
            }
        }
        if constexpr (ALIGN_EPI) { if (wr == 0) PG8_BAR; }
        if constexpr (!Epi::AFTER_DRAIN) { E(acc, cur, wr, wc, fr, fq); S.done(cur); }
        if (!has_next) break;
#pragma unroll
        for (int a = 0; a < 2; ++a)
#pragma unroll
            for (int b = 0; b < 2; ++b)
#pragma unroll
                for (int m = 0; m < 4; ++m)
#pragma unroll
                    for (int n = 0; n < 2; ++n) acc[a][b][m][n] = (f32x4){0.f, 0.f, 0.f, 0.f};
        cur = nxt; cA = nA; cB = nB; ++ui;
        if constexpr (ALIGN_EPI) { if (wr == 1) PG8_BAR; }
    }
    PG8_WAIT_V(0);
    if constexpr (!ALIGN_EPI) { if (wr == 0) PG8_BAR; }
    PG8_BAR;
    if constexpr (Epi::AFTER_DRAIN) { E.fused(acc, cur, wr, wc, fr, fq, lds, wid, lane); S.done(cur); }
#undef PG8_SA
#undef PG8_SB
#undef PG8_STAGE
#undef PG8_LDA
#undef PG8_LDB
#undef PG8_MMA
#undef PG8_WAIT_V
#undef PG8_WAIT_L
#undef PG8_BAR
#undef PG8_SCHED
}
}

#define LAS __attribute__((address_space(3)))
typedef unsigned short bf16_t;
typedef unsigned v4u __attribute__((ext_vector_type(4)));
typedef unsigned v2u __attribute__((ext_vector_type(2)));
typedef float f32x4 __attribute__((ext_vector_type(4)));
constexpr int NT = 512, NWAVES = 8;
constexpr int BATCH = 4, SEQ = 4096, DM = 1024, MROWS = BATCH * SEQ, DPROJ = 2304, DFF = 2816, PLE = 256, DEPTH = 4;
constexpr float EPS = 1e-6f;
constexpr int LDS_BYTES = 147456;
constexpr size_t MiB = 1u << 20;
constexpr size_t WS_WIN = 1 * MiB, WS_WOUT = 6 * MiB, WS_WUP = 8 * MiB, WS_WDN = 19 * MiB, WS_WPG = 25 * MiB, WS_WPE = 27 * MiB;
constexpr size_t WS_RGA = 28 * MiB, WS_RGH = 28 * MiB + 512 * 1024, WS_CARRY = 29 * MiB, WS_DEC = 30 * MiB;
constexpr size_t WS_H = 32 * MiB, WS_PBF = 64 * MiB, WS_ACT = 160 * MiB  , WS_HF = 160 * MiB;
constexpr size_t WS_Z = 160 * MiB, WS_MIX = 232 * MiB, WS_ST = 264 * MiB, WS_HL = 280 * MiB, WS_CA = 288 * MiB;
constexpr size_t WS_WSM = 27 * MiB + 512 * 1024, WS_WAT = WS_WSM + 128 * 1024, WS_WXT = WS_WAT + 32 * 1024, WS_WDT = WS_WXT + 32 * 1024, WS_STB = 296 * MiB;
constexpr size_t WS_SS = 336 * MiB, WS_XB1 = 304 * MiB;
constexpr size_t WS_PE = 72 * MiB;
constexpr size_t WS_END = 349 * MiB;

__device__ __forceinline__ float bf2f(bf16_t v) { return __uint_as_float(((unsigned)v) << 16); }
__device__ __forceinline__ float bflo(unsigned w) { return __uint_as_float(w << 16); }
__device__ __forceinline__ float bfhi(unsigned w) { return __uint_as_float(w & 0xffff0000u); }
__device__ __forceinline__ unsigned pk2(float lo, float hi) { unsigned r; asm("v_cvt_pk_bf16_f32 %0, %1, %2" : "=v"(r) : "v"(lo), "v"(hi)); return r; }
__device__ __forceinline__ unsigned f2bf(float f) { return pk2(f, f) & 0xffffu; }
__device__ __forceinline__ float frcp(float x) { return __builtin_amdgcn_rcpf(x); }
__device__ __forceinline__ float sigm(float x) { return frcp(1.f + __builtin_amdgcn_exp2f(-1.4426950408889634f * x)); }
__device__ __forceinline__ float gelu_t(float x) { return x * frcp(1.f + __builtin_amdgcn_exp2f(x * (-2.3022081980f + -0.1029432398f * (x * x)))); }
__device__ __forceinline__ float silu_(float x) { return x * frcp(1.f + __builtin_amdgcn_exp2f(-1.4426950408889634f * x)); }
__device__ __forceinline__ float wave_sum(float v) {
#pragma unroll
    for (int o = 1; o < 64; o <<= 1) v += __shfl_xor(v, o);
    return v;
}
#define LDS_WAIT() asm volatile("s_waitcnt lgkmcnt(0)" ::: "memory")

struct Params { const float* in[29]; float* out; unsigned char* ws; };

__device__ __forceinline__ void transpose_item(const float* W, int K, int N, bf16_t* WT, LAS float* scr, int item, int lane, const float* gk, bool ffn_perm = false) {
    const int nblk = N / 32, kb = item / nblk, nb = item % nblk, k0 = 64 * kb, n0 = 32 * nb;
    float wreg[32];
#pragma unroll
    for (int i = 0; i < 32; ++i) wreg[i] = W[(size_t)(k0 + 2 * i + (lane >> 5)) * N + n0 + (lane & 31)];
#pragma unroll
    for (int i = 0; i < 32; ++i) scr[(2 * i + (lane >> 5)) * 33 + (lane & 31)] = wreg[i];
    LDS_WAIT(); asm volatile("" ::: "memory");
    const int c = lane & 7;
#pragma unroll
    for (int j = 0; j < 4; ++j) { const int n = (lane >> 3) + 8 * j; const LAS float* s = scr + (8 * c) * 33 + n;
        f32x4 ga = {1.f, 1.f, 1.f, 1.f}, gb = {1.f, 1.f, 1.f, 1.f}; if (gk) { ga = *(const f32x4*)(gk + k0 + 8 * c); gb = *(const f32x4*)(gk + k0 + 8 * c + 4); }
        v4u o; o.x = pk2(s[0 * 33] * ga.x, s[1 * 33] * ga.y); o.y = pk2(s[2 * 33] * ga.z, s[3 * 33] * ga.w); o.z = pk2(s[4 * 33] * gb.x, s[5 * 33] * gb.y); o.w = pk2(s[6 * 33] * gb.z, s[7 * 33] * gb.w);
        int nr = n0 + n; if (ffn_perm) { const int hv = nr / DFF, cc = nr % DFF; nr = (cc >> 7) * 256 + hv * 128 + (cc & 127); }
        *(v4u*)(WT + (size_t)nr * K + k0 + 8 * c) = o; }
    LDS_WAIT(); asm volatile("" ::: "memory");
}

typedef short bf16x8 __attribute__((ext_vector_type(8)));
#define MFMA16(a, b, c) __builtin_amdgcn_mfma_f32_16x16x32_bf16((a), (b), (c), 0, 0, 0)
__device__ __forceinline__ bf16x8 ldsfrag(const LAS bf16_t* base, int row, int pitch, int k) { return *(const LAS bf16x8*)(base + row * pitch + k); }

__device__ __forceinline__ void gmlp2_unit(const Params& P, int l, int unit, LAS unsigned char* lds, int tid) {
    const int lane = tid & 63, wave = __builtin_amdgcn_readfirstlane(tid >> 6), lr = lane & 15, lq = lane >> 4;
    const int hp = unit & 1, n = (unit >> 1) & 31, b = unit >> 6; const size_t row0 = (size_t)b * SEQ + n * 128;
    LAS bf16_t* vnT = (LAS bf16_t*)lds;
    const bf16_t* Z = (const bf16_t*)(P.ws + WS_Z); bf16_t* MIX = (bf16_t*)(P.ws + WS_MIX); const bf16_t* WSM = (const bf16_t*)(P.ws + WS_WSM);
    const float* bs = P.in[7] + l * 4 * 128;
    {
        const f32x4 g4 = ((const f32x4*)(P.in[4] + l * 256))[lane], b4 = ((const f32x4*)(P.in[5] + l * 256))[lane];
        v2u raw[16];
#pragma unroll
        for (int tt = 0; tt < 16; ++tt) raw[tt] = *(const v2u*)(Z + (row0 + wave * 16 + tt) * DPROJ + 256 + lane * 4);
        __builtin_amdgcn_sched_barrier(0);
        unsigned pk[4][8];
#pragma unroll
        for (int hb = 0; hb < 2; ++hb) {
            float s1[8], s2[8];
#pragma unroll
            for (int t8 = 0; t8 < 8; ++t8) { const int tt = hb * 8 + t8; const float v0 = gelu_t(bflo(raw[tt].x)), v1 = gelu_t(bfhi(raw[tt].x)), v2 = gelu_t(bflo(raw[tt].y)), v3 = gelu_t(bfhi(raw[tt].y));
                raw[tt].x = pk2(v0, v1); raw[tt].y = pk2(v2, v3);
                const float w0 = bflo(raw[tt].x), w1 = bfhi(raw[tt].x), w2 = bflo(raw[tt].y), w3 = bfhi(raw[tt].y);
                s1[t8] = (w0 + w1) + (w2 + w3); s2[t8] = (w0 * w0 + w1 * w1) + (w2 * w2 + w3 * w3); }
#pragma unroll
            for (int o = 1; o < 64; o <<= 1) {
#pragma unroll
                for (int t8 = 0; t8 < 8; ++t8) { s1[t8] += __shfl_xor(s1[t8], o); s2[t8] += __shfl_xor(s2[t8], o); } }
#pragma unroll
            for (int t8 = 0; t8 < 8; ++t8) { const int tt = hb * 8 + t8;
                const float mu = s1[t8] * (1.f / 256.f); const float var = fmaxf(s2[t8] * (1.f / 256.f) - mu * mu, 0.f); const float rstd = rsqrtf(var + EPS);
                const float v0 = bflo(raw[tt].x) - mu, v1 = bfhi(raw[tt].x) - mu, v2 = bflo(raw[tt].y) - mu, v3 = bfhi(raw[tt].y) - mu;
                const unsigned o0 = f2bf(v0 * rstd * g4.x + b4.x), o1 = f2bf(v1 * rstd * g4.y + b4.y), o2 = f2bf(v2 * rstd * g4.z + b4.z), o3 = f2bf(v3 * rstd * g4.w + b4.w);
                if (tt & 1) { pk[0][tt >> 1] |= o0 << 16; pk[1][tt >> 1] |= o1 << 16; pk[2][tt >> 1] |= o2 << 16; pk[3][tt >> 1] |= o3 << 16; }
                else { pk[0][tt >> 1] = o0; pk[1][tt >> 1] = o1; pk[2][tt >> 1] = o2; pk[3][tt >> 1] = o3; }
            }
            asm volatile("" ::: "memory");
        }
        if ((lane >> 5) == hp) {
#pragma unroll
            for (int i = 0; i < 4; ++i) { LAS v4u* dst = (LAS v4u*)(vnT + ((lane & 31) * 4 + i) * 136 + wave * 16);
                dst[0] = (v4u){pk[i][0], pk[i][1], pk[i][2], pk[i][3]}; dst[1] = (v4u){pk[i][4], pk[i][5], pk[i][6], pk[i][7]}; }
        }
    }
    __syncthreads();
    const int t0 = wave * 16, nks = (wave >> 1) + 1;
#pragma unroll
    for (int hl = 0; hl < 2; ++hl) {
        const int h = hp * 2 + hl;
        f32x4 acc[4];
#pragma unroll
        for (int nt = 0; nt < 4; ++nt) acc[nt] = (f32x4){0.f, 0.f, 0.f, 0.f};
        v2u uraw[4];
#pragma unroll
        for (int nt = 0; nt < 4; ++nt) uraw[nt] = *(const v2u*)(Z + (row0 + t0 + lr) * DPROJ + h * 64 + nt * 16 + lq * 4);
        const float bsv = bs[h * 128 + t0 + lr];
        bf16x8 af[4];
#pragma unroll
        for (int ks = 0; ks < 4; ++ks) af[ks] = *(const bf16x8*)(WSM + ((size_t)(h * 128 + t0 + lr)) * 128 + (ks < nks ? ks : 0) * 32 + lq * 8);
        __builtin_amdgcn_sched_barrier(0);
#pragma unroll
        for (int ks = 0; ks < 4; ++ks) if (ks < nks) {
#pragma unroll
            for (int nt = 0; nt < 4; ++nt) acc[nt] = MFMA16(ldsfrag(vnT, hl * 64 + nt * 16 + lr, 136, ks * 32 + lq * 8), af[ks], acc[nt]);
        }
#pragma unroll
        for (int nt = 0; nt < 4; ++nt) { v2u w;
            w.x = pk2(gelu_t(bflo(uraw[nt].x)) * (acc[nt][0] + bsv), gelu_t(bfhi(uraw[nt].x)) * (acc[nt][1] + bsv));
            w.y = pk2(gelu_t(bflo(uraw[nt].y)) * (acc[nt][2] + bsv), gelu_t(bfhi(uraw[nt].y)) * (acc[nt][3] + bsv));
            *(v2u*)(MIX + (row0 + t0 + lr) * DM + h * 64 + nt * 16 + lq * 4) = w; }
    }
    __syncthreads();
}

__device__ __forceinline__ void pool2_unit(const Params& P, int l, int unit, LAS unsigned char* lds, int tid) {
    const int lane = tid & 63, wave = __builtin_amdgcn_readfirstlane(tid >> 6), lr = lane & 15, lq = lane >> 4;
    const int b = unit >> 6, n = unit & 63; const size_t row0 = (size_t)b * SEQ + n * 64;
    LAS float* raw = (LAS float*)lds;
    LAS bf16_t* plB = (LAS bf16_t*)(lds + 79 * 256 * 4);
    const bf16_t* Z = (const bf16_t*)(P.ws + WS_Z); bf16_t* MIX = (bf16_t*)(P.ws + WS_MIX); const bf16_t* WDT = (const bf16_t*)(P.ws + WS_WDT);
    { const int c = tid & 255, half = tid >> 8; bf16_t rv[40];
      const bf16_t* zc = Z + ((size_t)b * SEQ) * DPROJ + 2048 + c;
#pragma unroll
      for (int i = 0; i < 40; ++i) { int r = half + 2 * i; r = r < 79 ? r : 78; int tp = n * 64 - 15 + r; tp = tp >= 0 ? tp : 0; rv[i] = zc[(size_t)tp * DPROJ]; }
      __builtin_amdgcn_sched_barrier(0);
#pragma unroll
      for (int i = 0; i < 40; ++i) { const int r = half + 2 * i; if (r < 79) raw[r * 256 + c] = (n * 64 - 15 + r >= 0) ? bf2f(rv[i]) : 0.f; } }
    __syncthreads();
    { const int c = tid & 255, half = tid >> 8, w = 2 << (c >> 6), tb = half * 32;
      float s = 0.f; for (int j = 1; j < w; ++j) s += raw[(15 + tb - j) * 256 + c];
#pragma unroll 8
      for (int i = 0; i < 32; ++i) { const int t = tb + i; const float cur = raw[(15 + t) * 256 + c]; s += cur;
          const int pos1 = n * 64 + t + 1; const float cnt = (float)(pos1 < w ? pos1 : w);
          plB[t * 264 + c] = (bf16_t)f2bf(s * frcp(cnt) - cur);
          s -= raw[(15 + t - w + 1) * 256 + c]; } }
    __syncthreads();
    const int g = wave >> 1, ntp = wave & 1;
    bf16x8 Bf[2][2];
#pragma unroll
    for (int n2 = 0; n2 < 2; ++n2)
#pragma unroll
        for (int ks = 0; ks < 2; ++ks) Bf[n2][ks] = *(const bf16x8*)(WDT + ((size_t)(g * 64 + (ntp * 2 + n2) * 16 + lr)) * 64 + ks * 32 + lq * 8);
    f32x4 sc[2];
#pragma unroll
    for (int n2 = 0; n2 < 2; ++n2) sc[n2] = *(const f32x4*)(P.in[18] + l * 256 + g * 64 + (ntp * 2 + n2) * 16 + lq * 4);
#pragma unroll
    for (int mt = 0; mt < 4; ++mt) {
        f32x4 acc[2] = {(f32x4){0.f, 0.f, 0.f, 0.f}, (f32x4){0.f, 0.f, 0.f, 0.f}};
#pragma unroll
        for (int ks = 0; ks < 2; ++ks) { const bf16x8 a = ldsfrag(plB, mt * 16 + lr, 264, g * 64 + ks * 32 + lq * 8);
#pragma unroll
            for (int n2 = 0; n2 < 2; ++n2) acc[n2] = MFMA16(Bf[n2][ks], a, acc[n2]); }
#pragma unroll
        for (int n2 = 0; n2 < 2; ++n2) { const f32x4 y = acc[n2] * sc[n2]; v2u w; w.x = pk2(y[0], y[1]); w.y = pk2(y[2], y[3]);
            *(v2u*)(MIX + (row0 + mt * 16 + lr) * DM + 768 + g * 64 + (ntp * 2 + n2) * 16 + lq * 4) = w; }
    }
    __syncthreads();
}

__device__ __forceinline__ void rglru2_unit(const Params& P, int l, int unit, LAS unsigned char* lds, int tid) {
    const int lane = tid & 63, wave = __builtin_amdgcn_readfirstlane(tid >> 6), lr = lane & 15, lq = lane >> 4;
    const int b = unit >> 6, k = unit & 63; const size_t row0 = (size_t)b * SEQ + k * 64;
    LAS float* xcF = (LAS float*)lds;
    LAS bf16_t* xcB = (LAS bf16_t*)(lds + 64 * 256 * 4);
    const bf16_t* Z = (const bf16_t*)(P.ws + WS_Z);
    bf16_t* HL = (bf16_t*)(P.ws + WS_HL); bf16_t* CA = (bf16_t*)(P.ws + WS_CA);
    float* RGA = (float*)(P.ws + WS_RGA); float* RGH = (float*)(P.ws + WS_RGH);
    const bf16_t* WAT = (const bf16_t*)(P.ws + WS_WAT); const bf16_t* WXT = (const bf16_t*)(P.ws + WS_WXT);
    {
        const int c = tid & 255, half = tid >> 8, tp0 = k * 64 + half * 32;
        const float* cwp = P.in[8] + (size_t)l * 4 * 256 + c;
        const float cw0 = cwp[0], cw1 = cwp[256], cw2 = cwp[512], cw3 = cwp[768], cb = P.in[9][l * 256 + c];
        const bf16_t* zb = Z + ((size_t)b * SEQ) * DPROJ + 512 + c;
        float xr[35];
#pragma unroll
        for (int i = 0; i < 35; ++i) { const int tp = tp0 - 3 + i; xr[i] = __uint_as_float((unsigned)zb[(size_t)(tp >= 0 ? tp : 0) * DPROJ] << 16); }
        __builtin_amdgcn_sched_barrier(0);
#pragma unroll
        for (int i = 0; i < 3; ++i) { asm volatile("" : "+v"(xr[i])); xr[i] = (tp0 - 3 + i >= 0) ? xr[i] : 0.f; }
#pragma unroll
        for (int tt = 0; tt < 32; ++tt) { const float xc = cb + cw0 * xr[tt] + cw1 * xr[tt + 1] + cw2 * xr[tt + 2] + cw3 * xr[tt + 3];
            xcF[(half * 32 + tt) * 256 + c] = xc; xcB[(half * 32 + tt) * 264 + c] = (bf16_t)f2bf(xc); }
    }
    __syncthreads();
    const int h = wave >> 1, ntp = wave & 1;
    bf16x8 Ba[2][2], Bx[2][2];
#pragma unroll
    for (int n2 = 0; n2 < 2; ++n2)
#pragma unroll
        for (int ks = 0; ks < 2; ++ks) { const size_t off = ((size_t)(h * 64 + (ntp * 2 + n2) * 16 + lr)) * 64 + ks * 32 + lq * 8;
            Ba[n2][ks] = *(const bf16x8*)(WAT + off); Bx[n2][ks] = *(const bf16x8*)(WXT + off); }
    float carryH[2] = {0.f, 0.f}, carryA[2] = {1.f, 1.f};
    float ba[2], bx[2], sp[2];
#pragma unroll
    for (int n2 = 0; n2 < 2; ++n2) { const int c = h * 64 + (ntp * 2 + n2) * 16 + lr; ba[n2] = P.in[11][l * 256 + c]; bx[n2] = P.in[13][l * 256 + c]; sp[n2] = log1pf(__expf(-P.in[14][l * 256 + c])); }
#pragma unroll
    for (int mt = 0; mt < 4; ++mt) {
        float gbv[2][4];
#pragma unroll
        for (int n2 = 0; n2 < 2; ++n2)
#pragma unroll
            for (int jj = 0; jj < 4; ++jj) gbv[n2][jj] = bf2f(Z[(row0 + mt * 16 + lq * 4 + jj) * DPROJ + 768 + h * 64 + (ntp * 2 + n2) * 16 + lr]);
        f32x4 accA[2] = {(f32x4){0.f, 0.f, 0.f, 0.f}, (f32x4){0.f, 0.f, 0.f, 0.f}}, accX[2] = {(f32x4){0.f, 0.f, 0.f, 0.f}, (f32x4){0.f, 0.f, 0.f, 0.f}};
#pragma unroll
        for (int ks = 0; ks < 2; ++ks) { const bf16x8 a = ldsfrag(xcB, mt * 16 + lr, 264, h * 64 + ks * 32 + lq * 8);
#pragma unroll
            for (int n2 = 0; n2 < 2; ++n2) { accA[n2] = MFMA16(a, Ba[n2][ks], accA[n2]); accX[n2] = MFMA16(a, Bx[n2][ks], accX[n2]); } }
#pragma unroll
        for (int n2 = 0; n2 < 2; ++n2) {
            const int c = h * 64 + (ntp * 2 + n2) * 16 + lr;
            float aloc[4], hloc[4]; float hrun = 0.f, cum = 1.f;
#pragma unroll
            for (int jj = 0; jj < 4; ++jj) { const int t = mt * 16 + lq * 4 + jj;
                const float r = sigm(accA[n2][jj] + ba[n2]), ig = sigm(accX[n2][jj] + bx[n2]); const float la = -8.f * r * sp[n2]; const float a = __expf(la);
                const float x2 = 2.f * la; const float m2 = (x2 > -0.02f) ? -(x2 * (1.f + x2 * (0.5f + x2 * (0.16666667f + x2 * 0.041666668f)))) : 1.f - a * a;
                const float bt = __builtin_amdgcn_sqrtf(m2) * ig * xcF[t * 256 + c]; hrun = a * hrun + bt; cum *= a; hloc[jj] = hrun; aloc[jj] = cum; }
            float Ae = cum, He = hrun;
            { const float A1 = __shfl_up(Ae, 16), H1 = __shfl_up(He, 16); if (lq >= 1) { He = Ae * H1 + He; Ae = Ae * A1; } }
            { const float A2 = __shfl_up(Ae, 32), H2 = __shfl_up(He, 32); if (lq >= 2) { He = Ae * H2 + He; Ae = Ae * A2; } }
            float Ax = __shfl_up(Ae, 16), Hx = __shfl_up(He, 16); if (lq == 0) { Ax = 1.f; Hx = 0.f; }
            const float Hs = Ax * carryH[n2] + Hx, As = carryA[n2] * Ax;
            const float Ab = __shfl(Ae, 48 + lr), Hb = __shfl(He, 48 + lr);
            carryH[n2] = Ab * carryH[n2] + Hb; carryA[n2] = carryA[n2] * Ab;
#pragma unroll
            for (int jj = 0; jj < 4; ++jj) { const size_t r = row0 + mt * 16 + lq * 4 + jj; const float gg = gelu_t(gbv[n2][jj]);
                HL[r * 256 + c] = (bf16_t)f2bf((aloc[jj] * Hs + hloc[jj]) * gg); CA[r * 256 + c] = (bf16_t)f2bf(As * aloc[jj] * gg); }
        }
    }
    if (lq == 0) {
#pragma unroll
        for (int n2 = 0; n2 < 2; ++n2) { const int c = h * 64 + (ntp * 2 + n2) * 16 + lr; RGA[((size_t)b * 64 + k) * 256 + c] = carryA[n2]; RGH[((size_t)b * 64 + k) * 256 + c] = carryH[n2]; }
    }
    __syncthreads();
}

template <int MODE>
__device__ __forceinline__ void hgrn2_unit(const Params& P, int l, int unit, LAS unsigned char* lds, int tid) {
    const int lane = tid & 63, wave = __builtin_amdgcn_readfirstlane(tid >> 6), lr = lane & 15, lq = lane >> 4;
    const int hp = unit & 1, n = (unit >> 1) & 63, b = unit >> 7; const size_t row0 = (size_t)b * SEQ + n * 64;
    LAS float* SEG = (LAS float*)(lds + 124928);
    LAS bf16_t* K2T = (LAS bf16_t*)lds;
    LAS bf16_t* VT = (LAS bf16_t*)(lds + (MODE == 0 ? 18432 : 52224));
    LAS bf16_t* QS = (LAS bf16_t*)lds;
    LAS bf16_t* KS = (LAS bf16_t*)(lds + 17408);
    LAS bf16_t* Q2 = (LAS bf16_t*)(lds + 34816);
    LAS bf16_t* PP = (LAS bf16_t*)(lds + 70656) + wave * 16 * 72;
    const bf16_t* Z = (const bf16_t*)(P.ws + WS_Z); bf16_t* MIX = (bf16_t*)(P.ws + WS_MIX);
    {
        const int c = tid & 127, sg = tid >> 7, ch = hp * 128 + c;
        float lb;
        { const float* clb = P.in[15] + ch; const float c0 = clb[0], c1 = clb[256], c2 = clb[512], c3 = clb[768];
          const float mx = fmaxf(fmaxf(c0, c1), fmaxf(c2, c3)); const float e0 = __expf(c0 - mx), e1 = __expf(c1 - mx), e2 = __expf(c2 - mx), e3 = __expf(c3 - mx);
          const float num = (l >= 1 ? e1 : 0.f) + (l >= 2 ? e2 : 0.f) + (l >= 3 ? e3 : 0.f); lb = num / (e0 + e1 + e2 + e3); }
        const bf16_t* zr = Z + (row0 + sg * 16) * DPROJ + 1024 + ch;
        float fr[16], iv[16], qv[16];
#pragma unroll
        for (int j = 0; j < 16; ++j) { fr[j] = bf2f(zr[(size_t)j * DPROJ + 256]); iv[j] = bf2f(zr[(size_t)j * DPROJ + 512]); if (MODE == 1) qv[j] = bf2f(zr[(size_t)j * DPROJ]); }
        float pre[16], kf[16]; float run = 0.f;
#pragma unroll
        for (int j = 0; j < 16; ++j) { const float fg = lb + (1.f - lb) * sigm(fr[j]); kf[j] = 1.f - fg; run += __logf(fg); pre[j] = run; }
        SEG[sg * 128 + c] = run;
        __syncthreads();
        const float s0 = SEG[c], s1 = SEG[128 + c], s2 = SEG[256 + c], s3 = SEG[384 + c];
        const float off = (sg >= 1 ? s0 : 0.f) + (sg >= 2 ? s1 : 0.f) + (sg >= 3 ? s2 : 0.f);
        const float bm = s0 + s1, bl = (s0 + s1) + (s2 + s3);
        unsigned pv[8], pk2_[8];
#pragma unroll
        for (int j = 0; j < 16; ++j) {
            const float bb = off + pre[j]; const int t = sg * 16 + j;
            const unsigned vb = f2bf(iv[j]);
            if (j & 1) pv[j >> 1] |= vb << 16; else pv[j >> 1] = vb;
            if (MODE == 0) { const unsigned kb = f2bf(kf[j] * __expf(bl - bb)); if (j & 1) pk2_[j >> 1] |= kb << 16; else pk2_[j >> 1] = kb; }
            else { const float q = silu_(qv[j]);
                QS[t * 136 + c] = (bf16_t)f2bf(q * __expf(bb - bm)); KS[t * 136 + c] = (bf16_t)f2bf(kf[j] * __expf(bm - bb)); Q2[t * 136 + c] = (bf16_t)f2bf(q * __expf(bb)); }
        }
        { LAS v4u* dst = (LAS v4u*)(VT + c * 72 + sg * 16); dst[0] = (v4u){pv[0], pv[1], pv[2], pv[3]}; dst[1] = (v4u){pv[4], pv[5], pv[6], pv[7]}; }
        if (MODE == 0) { LAS v4u* dst = (LAS v4u*)(K2T + c * 72 + sg * 16); dst[0] = (v4u){pk2_[0], pk2_[1], pk2_[2], pk2_[3]}; dst[1] = (v4u){pk2_[4], pk2_[5], pk2_[6], pk2_[7]};
            if (sg == 0) { const int bh = b * 4 + hp * 2 + (c >> 6); ((float*)(P.ws + WS_DEC))[((size_t)bh * 64 + n) * 64 + (c & 63)] = __expf(bl); } }
    }
    __syncthreads();
    const int hl = wave >> 2, w4 = wave & 3, bh = b * 4 + hp * 2 + hl, h = hp * 2 + hl;
    if (MODE == 0) {
        float* ST = (float*)(P.ws + WS_ST) + ((size_t)bh * 64 + n) * 4096;
        f32x4 acc[4];
#pragma unroll
        for (int dt = 0; dt < 4; ++dt) acc[dt] = (f32x4){0.f, 0.f, 0.f, 0.f};
#pragma unroll
        for (int ks = 0; ks < 2; ++ks) { const bf16x8 a = ldsfrag(VT, hl * 64 + w4 * 16 + lr, 72, ks * 32 + lq * 8);
#pragma unroll
            for (int dt = 0; dt < 4; ++dt) acc[dt] = MFMA16(ldsfrag(K2T, hl * 64 + dt * 16 + lr, 72, ks * 32 + lq * 8), a, acc[dt]); }
#pragma unroll
        for (int dt = 0; dt < 4; ++dt) *(f32x4*)(ST + (w4 * 16 + lr) * 64 + dt * 16 + lq * 4) = acc[dt];
    } else {
        const int mt = w4;
        const bf16_t* STB = (const bf16_t*)(P.ws + WS_STB) + ((size_t)bh * 64 + n) * 4096;
        bf16x8 Sf[4][2];
#pragma unroll
        for (int nt = 0; nt < 4; ++nt)
#pragma unroll
            for (int ks = 0; ks < 2; ++ks) Sf[nt][ks] = *(const bf16x8*)(STB + (nt * 16 + lr) * 64 + ks * 32 + lq * 8);
        float gv[4][4];
#pragma unroll
        for (int nt = 0; nt < 4; ++nt)
#pragma unroll
            for (int jj = 0; jj < 4; ++jj) gv[nt][jj] = bf2f(Z[(row0 + mt * 16 + lq * 4 + jj) * DPROJ + 1792 + h * 64 + nt * 16 + lr]);
        float ng[4];
#pragma unroll
        for (int nt = 0; nt < 4; ++nt) ng[nt] = P.in[16][l * 64 + nt * 16 + lr];
        const bf16x8 qa0 = ldsfrag(QS, mt * 16 + lr, 136, hl * 64 + lq * 8), qa1 = ldsfrag(QS, mt * 16 + lr, 136, hl * 64 + 32 + lq * 8);
#pragma unroll
        for (int st = 0; st < 4; ++st) {
            f32x4 s = (f32x4){0.f, 0.f, 0.f, 0.f};
            if (st <= mt) { s = MFMA16(qa0, ldsfrag(KS, st * 16 + lr, 136, hl * 64 + lq * 8), s); s = MFMA16(qa1, ldsfrag(KS, st * 16 + lr, 136, hl * 64 + 32 + lq * 8), s); }
#pragma unroll
            for (int jj = 0; jj < 4; ++jj) { const bool keep = (st < mt) || (st == mt && lr <= lq * 4 + jj); PP[(lq * 4 + jj) * 72 + st * 16 + lr] = (bf16_t)f2bf(keep ? s[jj] : 0.f); }
        }
        f32x4 acc[4];
#pragma unroll
        for (int nt = 0; nt < 4; ++nt) acc[nt] = (f32x4){0.f, 0.f, 0.f, 0.f};
        const bf16x8 q20 = ldsfrag(Q2, mt * 16 + lr, 136, hl * 64 + lq * 8), q21 = ldsfrag(Q2, mt * 16 + lr, 136, hl * 64 + 32 + lq * 8);
#pragma unroll
        for (int nt = 0; nt < 4; ++nt) { acc[nt] = MFMA16(q20, Sf[nt][0], acc[nt]); acc[nt] = MFMA16(q21, Sf[nt][1], acc[nt]); }
#pragma unroll
        for (int ks = 0; ks < 2; ++ks) if (ks * 2 <= mt) { const bf16x8 pa = ldsfrag(PP, lr, 72, ks * 32 + lq * 8);
#pragma unroll
            for (int nt = 0; nt < 4; ++nt) acc[nt] = MFMA16(pa, ldsfrag(VT, hl * 64 + nt * 16 + lr, 72, ks * 32 + lq * 8), acc[nt]); }
#pragma unroll
        for (int jj = 0; jj < 4; ++jj) {
            float ss = (acc[0][jj] * acc[0][jj] + acc[1][jj] * acc[1][jj]) + (acc[2][jj] * acc[2][jj] + acc[3][jj] * acc[3][jj]);
            ss += __shfl_xor(ss, 1); ss += __shfl_xor(ss, 2); ss += __shfl_xor(ss, 4); ss += __shfl_xor(ss, 8);
            const float rstd = rsqrtf(ss * (1.f / 64.f) + EPS);
#pragma unroll
            for (int nt = 0; nt < 4; ++nt) MIX[(row0 + mt * 16 + lq * 4 + jj) * DM + 512 + h * 64 + nt * 16 + lr] = (bf16_t)f2bf(acc[nt][jj] * rstd * ng[nt] * silu_(gv[nt][jj]));
        }
    }
    __syncthreads();
}

#define RLX_AGENT __ATOMIC_RELAXED, __HIP_MEMORY_SCOPE_AGENT
#define XB_TMO      128
#define XB_XCNT(j)  (256  + 64 * (j))
#define XB_XSUB(j)  (1280 + 64 * (j))
#define XB_XGEN(j)  (2304 + 64 * (j))
#define XB_TOP      3328
#define XB_TOPGEN   3392
#define XCD_BAR_WORDS 3456
#define XB_SPIN_CAP (1u << 18)

__device__ __forceinline__ unsigned xb_ld(unsigned* p)              { return __hip_atomic_load(p, __ATOMIC_RELAXED, __HIP_MEMORY_SCOPE_AGENT); }
__device__ __forceinline__ unsigned xb_add(unsigned* p, unsigned v) { return __hip_atomic_fetch_add(p, v, __ATOMIC_RELAXED, __HIP_MEMORY_SCOPE_AGENT); }
__device__ __forceinline__ unsigned xb_xcc_id() { return (unsigned)__builtin_amdgcn_s_getreg((3 << 11) | 20) & 0xFu; }
#define XB_SPIN(cond, bar) do { unsigned _sp = 0; while (cond) { __builtin_amdgcn_s_sleep(1); \
    if ((++_sp & 255u) == 0u) { if (xb_ld(&(bar)[XB_TMO])) break; if (_sp > XB_SPIN_CAP) { atomicAdd(&(bar)[XB_TMO], 1u); break; } } } } while (0)

struct XcdBarrier {
    unsigned* bar; unsigned x;
    volatile LAS unsigned* st;
};

__device__ __forceinline__ XcdBarrier xcd_barrier_post(unsigned* bar, volatile LAS unsigned* st) {
    XcdBarrier b; b.bar = bar; b.x = xb_xcc_id(); b.st = st;
    if (threadIdx.x == 0) (void)xb_add(&bar[XB_XCNT(b.x)], 1u);
    return b;
}
__device__ __forceinline__ void xcd_barrier_complete(unsigned* bar, unsigned x, unsigned& nloc, unsigned& nx) {
    const unsigned G = gridDim.x * gridDim.y * gridDim.z;
    unsigned sum, cnt, mine, sp = 0u;
    for (;;) {
        sum = 0u; cnt = 0u; mine = 0u;
#pragma unroll
        for (unsigned j = 0; j < 16; ++j) { const unsigned c = xb_ld(&bar[XB_XCNT(j)]); sum += c; cnt += (c > 0u) ? 1u : 0u; mine = (j == x) ? c : mine; }
        if (sum == G) break;
        __builtin_amdgcn_s_sleep(1);
        if ((++sp & 255u) == 0u) { if (xb_ld(&bar[XB_TMO])) break; if (sp > XB_SPIN_CAP) { atomicAdd(&bar[XB_TMO], 1u); break; } }
    }
    nloc = mine > 0u ? mine : 1u; nx = cnt > 0u ? cnt : 1u;
}

__device__ __forceinline__ void xcd_barrier(const XcdBarrier& b) {
    asm volatile("s_waitcnt vmcnt(0)" ::: "memory");
    __syncthreads();
    if (threadIdx.x == 0) {
        unsigned* bar = b.bar;
        __builtin_amdgcn_s_waitcnt(0);
        unsigned nloc = b.st[0], nx = b.st[1];
        if (nloc == 0u) { xcd_barrier_complete(bar, b.x, nloc, nx); b.st[0] = nloc; b.st[1] = nx; }
        const unsigned old = xb_add(&bar[XB_XSUB(b.x)], 1u);
        const unsigned gen = old / nloc;
        if (old + 1u == (gen + 1u) * nloc) {
            __builtin_amdgcn_fence(__ATOMIC_RELEASE, "agent");
            asm volatile("s_waitcnt vmcnt(0)" ::: "memory");
            const unsigned og = xb_add(&bar[XB_TOP], 1u);
            const unsigned tg = og / nx;
            if (og + 1u == (tg + 1u) * nx) xb_add(&bar[XB_TOPGEN], 1u);
            else XB_SPIN(xb_ld(&bar[XB_TOPGEN]) == tg, bar);
            __builtin_amdgcn_fence(__ATOMIC_ACQUIRE, "agent");
            xb_add(&bar[XB_XGEN(b.x)], 1u);
            asm volatile("s_waitcnt vmcnt(0)" ::: "memory");
        } else {
            XB_SPIN(xb_ld(&bar[XB_XGEN(b.x)]) == gen, bar);
            __builtin_amdgcn_fence(__ATOMIC_ACQUIRE, "agent");
            asm volatile("s_waitcnt vmcnt(0)" ::: "memory");
        }
    }
    __syncthreads();
}

__global__ void __launch_bounds__(NT, 2) mega_fwd(Params P) {
    extern __shared__ __attribute__((aligned(16))) unsigned char lds_raw[];
    LAS unsigned char* lds = (LAS unsigned char*)lds_raw;
    cg::grid_group grid = cg::this_grid();
    const int G = gridDim.x, bid = blockIdx.x;
    const int NGW = G * NWAVES, NTHR = G * NT;
    volatile LAS unsigned* MISC = (volatile LAS unsigned*)(lds + LDS_BYTES - 64);
    if (threadIdx.x < 16) MISC[threadIdx.x] = 0u;
    __syncthreads();
    XcdBarrier xbar = xcd_barrier_post((unsigned*)P.ws, MISC);
#define GSYNC() do { xcd_barrier(xbar); for (int r_ = 0; r_ < REP_SYNC; ++r_) xcd_barrier(xbar); } while (0)
#define TIDS int tid = threadIdx.x; asm volatile("" : "+v"(tid)); const int lane = tid & 63, wave = __builtin_amdgcn_readfirstlane(tid >> 6); const int gw = bid * NWAVES + wave, gtid = bid * NT + tid; (void)lane; (void)gw; (void)gtid;
    unsigned char* ws = P.ws;
    bf16_t* WIN = (bf16_t*)(ws + WS_WIN); bf16_t* WOUT = (bf16_t*)(ws + WS_WOUT); bf16_t* WUP = (bf16_t*)(ws + WS_WUP);
    bf16_t* WDN = (bf16_t*)(ws + WS_WDN); bf16_t* WPG = (bf16_t*)(ws + WS_WPG); bf16_t* WPE = (bf16_t*)(ws + WS_WPE);
    bf16_t* XB0 = (bf16_t*)(ws + WS_H); bf16_t* XB1 = (bf16_t*)(ws + WS_XB1); float* SS = (float*)(ws + WS_SS);
    bf16_t* PBF = (bf16_t*)(ws + WS_PBF); bf16_t* ACT = (bf16_t*)(ws + WS_ACT); bf16_t* HF = (bf16_t*)(ws + WS_HF);
    bf16_t* Zb = (bf16_t*)(ws + WS_Z); bf16_t* MIX = (bf16_t*)(ws + WS_MIX); bf16_t* PEb = (bf16_t*)(ws + WS_PE);
    float* X = P.out;

#define GEMM(Aop, Bop, Nn, Kk, MODE, Optr, LDC, SSI, SSO, XBO, XBI) do { pg8::Gemm g{Aop, Bop, MROWS, Nn, Kk, 0}; pg8::Epi<MODE> E{Optr, LDC, XBI, PEb, SSI, SSO, XBO, nullptr, nullptr, nullptr}; pg8::StaticOrder S; S.init(MROWS, Nn, G, bid); \
        pg8::gemm_phase<pg8::Epi<MODE>, pg8::StaticOrder, true, true>(lds, g, S, E); } while (0)
    for (int l_ = 0; l_ < DEPTH; ++l_) {
        {
            int l = l_; asm volatile("" : "+s"(l));
            bf16_t* XBc = XB0; bf16_t* XBn = XB1;     float* SSl = SS + (size_t)3 * l * MROWS * 16;
            for (int re_ = 0; re_ < REP_ELT; ++re_) {   TIDS
                LAS float* scr = (LAS float*)(lds + wave * 16384);
                const float* w_in = P.in[3] + (size_t)l * DM * DPROJ; const float* w_out = P.in[19] + (size_t)l * DM * DM; const float* w_up = P.in[21] + (size_t)l * DM * 2 * DFF;
                const float* w_dn = P.in[24] + (size_t)l * DFF * DM; const float* w_pe = P.in[26] + (size_t)l * PLE * DM; const float* w_pg = P.in[27] + (size_t)l * DM * DM;
                for (int it = gw; it < 6528; it += NGW) {
                    int r = it;
                    if (r < 1152) { transpose_item(w_in, DM, DPROJ, WIN, scr, r, lane, P.in[2] + l * DM); continue; } r -= 1152;
                    if (r < 512) { transpose_item(w_out, DM, DM, WOUT, scr, r, lane, nullptr); continue; } r -= 512;
                    if (r < 2816) { transpose_item(w_up, DM, 2 * DFF, WUP, scr, r, lane, P.in[20] + l * DM, true); continue; } r -= 2816;
                    if (r < 1408) { transpose_item(w_dn, DFF, DM, WDN, scr, r, lane, nullptr); continue; } r -= 1408;
                    if (r < 512) { transpose_item(w_pg, DM, DM, WPG, scr, r, lane, P.in[25] + l * DM); continue; } r -= 512;
                    transpose_item(w_pe, PLE, DM, WPE, scr, r, lane, nullptr);
                }
                const float* pl = P.in[1] + (size_t)l * MROWS * PLE;
                for (int i = gtid; i < MROWS * PLE / 8; i += NTHR) { const f32x4 a = ((const f32x4*)pl)[2 * i], b2 = ((const f32x4*)pl)[2 * i + 1];
                    v4u w; w.x = pk2(a.x, a.y); w.y = pk2(a.z, a.w); w.z = pk2(b2.x, b2.y); w.w = pk2(b2.z, b2.w); ((v4u*)PBF)[i] = w; }
                { bf16_t* WSM = (bf16_t*)(ws + WS_WSM); bf16_t* WAT = (bf16_t*)(ws + WS_WAT); bf16_t* WXT = (bf16_t*)(ws + WS_WXT); bf16_t* WDT = (bf16_t*)(ws + WS_WDT);
                  const float* aws = P.in[6] + (size_t)l * 65536; const float* bwa = P.in[10] + (size_t)l * 16384; const float* bwx = P.in[12] + (size_t)l * 16384; const float* dw = P.in[17] + (size_t)l * 16384;
                  for (int i = gtid; i < 65536 + 3 * 16384; i += NTHR) {
                      if (i < 65536) { const int t = (i >> 7) & 127, sx = i & 127; WSM[i] = (bf16_t)f2bf(sx <= t ? aws[i] : 0.f); }
                      else { const int r = i - 65536, m = r >> 14, q = r & 16383, hh = q >> 12, e = (q >> 6) & 63, d = q & 63; const int src = hh * 4096 + d * 64 + e;
                          if (m == 0) WAT[q] = (bf16_t)f2bf(bwa[src]); else if (m == 1) WXT[q] = (bf16_t)f2bf(bwx[src]); else WDT[q] = (bf16_t)f2bf(dw[src]); } } }
                if (l == 0) {
                    for (int m = gw; m < MROWS; m += NGW) {
                        const f32x4* xr = (const f32x4*)(P.in[0] + (size_t)m * DM) + lane; f32x4 v[4]; float sq = 0.f;
#pragma unroll
                        for (int j = 0; j < 4; ++j) { v[j] = xr[64 * j]; sq += (v[j].x * v[j].x + v[j].y * v[j].y) + (v[j].z * v[j].z + v[j].w * v[j].w); }
                        sq = wave_sum(sq); if (lane < 16) SS[(size_t)m * 16 + lane] = (lane == 0) ? sq : 0.f;
                        v2u* o8 = (v2u*)(XB1 + (size_t)m * DM) + lane;
#pragma unroll
                        for (int j = 0; j < 4; ++j) { v2u w; w.x = pk2(v[j].x, v[j].y); w.y = pk2(v[j].z, v[j].w); o8[64 * j] = w; }
                    }
                }
            }
            if (P.out == nullptr) grid.sync();
            GSYNC();
            GEMM(XBn, WIN, DPROJ, DM, 0, Zb, DPROJ, SSl, nullptr, nullptr, nullptr);
            {
                pg8::Gemm g{PBF, WPE, MROWS, DM, PLE, 0}; pg8::Epi<0> E{PEb, DM, nullptr, PEb, nullptr, nullptr, nullptr, nullptr, nullptr, nullptr};
                pg8::StaticOrder S; S.init(MROWS, DM, G > 64 ? G - 64 : G, G > 64 ? (bid >= 64 ? bid - 64 : (1 << 20)) : bid);
                pg8::gemm_phase<pg8::Epi<0>, pg8::StaticOrder, true, true>(lds, g, S, E); }
            GSYNC();
            for (int rm_ = 0; rm_ < REP_MIX; ++rm_) {
            {   TIDS
                for (int it = bid; it < 256 + 256 + 256 + 512; it += G) {
                    int t2 = tid; asm volatile("" : "+v"(t2));
                    if (it < 256) gmlp2_unit(P, l, it, lds, t2);
                    else if (it < 512) pool2_unit(P, l, it - 256, lds, t2);
                    else if (it < 768) rglru2_unit(P, l, it - 512, lds, t2);
                    else hgrn2_unit<0>(P, l, it - 768, lds, t2);
                }
            }
            GSYNC();
            {   TIDS
                if (gtid < 65536) { const int bh = gtid >> 12, e = gtid & 4095, d = e & 63; float s = 0.f;
                    const float* stp = (const float*)(ws + WS_ST) + (size_t)bh * 64 * 4096 + e; bf16_t* sbp = (bf16_t*)(ws + WS_STB) + (size_t)bh * 64 * 4096 + e; const float* dc = (const float*)(ws + WS_DEC) + bh * 64 * 64 + d;
#pragma unroll 1
                    for (int c0 = 0; c0 < 64; c0 += 16) { float kk[16], dd[16];
#pragma unroll
                        for (int j = 0; j < 16; ++j) { kk[j] = stp[(size_t)(c0 + j) * 4096]; dd[j] = dc[(c0 + j) * 64]; }
                        __builtin_amdgcn_sched_barrier(0);
#pragma unroll
                        for (int j = 0; j < 16; ++j) { sbp[(size_t)(c0 + j) * 4096] = (bf16_t)f2bf(s); s = dd[j] * s + kk[j]; } }
                } else if (gtid < 65536 + 1024) { const int q = gtid - 65536, b = q >> 8, c = q & 255; float carry = 0.f;
                    const float* ra = (const float*)(ws + WS_RGA) + (size_t)b * 64 * 256 + c; const float* rh = (const float*)(ws + WS_RGH) + (size_t)b * 64 * 256 + c; float* cr = (float*)(ws + WS_CARRY) + (size_t)b * 64 * 256 + c;
#pragma unroll 1
                    for (int k0 = 0; k0 < 64; k0 += 16) { float aa[16], hh[16];
#pragma unroll
                        for (int j = 0; j < 16; ++j) { aa[j] = ra[(k0 + j) * 256]; hh[j] = rh[(k0 + j) * 256]; }
                        __builtin_amdgcn_sched_barrier(0);
#pragma unroll
                        for (int j = 0; j < 16; ++j) { cr[(k0 + j) * 256] = carry; carry = aa[j] * carry + hh[j]; } }
                }
            }
            GSYNC();
            {   TIDS
                const v4u* HL = (const v4u*)(ws + WS_HL); const v4u* CA = (const v4u*)(ws + WS_CA); const float* cr = (const float*)(ws + WS_CARRY);
                for (int i0 = gtid; i0 < MROWS * 32; i0 += 2 * NTHR) {
                    const int i1 = i0 + NTHR; const bool v1 = i1 < MROWS * 32; const int ix = v1 ? i1 : i0;
                    const int rowa = i0 >> 5, c0a = (i0 & 31) * 8, rowb = ix >> 5, c0b = (ix & 31) * 8;
                    const v4u hla = HL[i0], caa = CA[i0], hlb = HL[ix], cab = CA[ix];
                    const f32x4* cpa = (const f32x4*)(cr + ((size_t)(rowa >> 12) * 64 + ((rowa & 4095) >> 6)) * 256 + c0a); const f32x4* cpb = (const f32x4*)(cr + ((size_t)(rowb >> 12) * 64 + ((rowb & 4095) >> 6)) * 256 + c0b);
                    const f32x4 a0 = cpa[0], a1 = cpa[1], b0 = cpb[0], b1 = cpb[1];
                    __builtin_amdgcn_sched_barrier(0);
                    { v4u w; w.x = pk2(bflo(hla.x) + bflo(caa.x) * a0.x, bfhi(hla.x) + bfhi(caa.x) * a0.y); w.y = pk2(bflo(hla.y) + bflo(caa.y) * a0.z, bfhi(hla.y) + bfhi(caa.y) * a0.w);
                      w.z = pk2(bflo(hla.z) + bflo(caa.z) * a1.x, bfhi(hla.z) + bfhi(caa.z) * a1.y); w.w = pk2(bflo(hla.w) + bflo(caa.w) * a1.z, bfhi(hla.w) + bfhi(caa.w) * a1.w);
                      *(v4u*)(MIX + (size_t)rowa * DM + 256 + c0a) = w; }
                    if (v1) { v4u w; w.x = pk2(bflo(hlb.x) + bflo(cab.x) * b0.x, bfhi(hlb.x) + bfhi(cab.x) * b0.y); w.y = pk2(bflo(hlb.y) + bflo(cab.y) * b0.z, bfhi(hlb.y) + bfhi(cab.y) * b0.w);
                      w.z = pk2(bflo(hlb.z) + bflo(cab.z) * b1.x, bfhi(hlb.z) + bfhi(cab.z) * b1.y); w.w = pk2(bflo(hlb.w) + bflo(cab.w) * b1.z, bfhi(hlb.w) + bfhi(cab.w) * b1.w);
                      *(v4u*)(MIX + (size_t)rowb * DM + 256 + c0b) = w; }
                }
                for (int it = bid; it < 512; it += G) { int t2 = tid; asm volatile("" : "+v"(t2)); hgrn2_unit<1>(P, l, it, lds, t2); }
            }
            GSYNC();
            }
            GEMM(MIX, WOUT, DM, DM, 1, nullptr, 0, nullptr, SSl + MROWS * 16, XBc, XBn);
            GSYNC();
            for (int r_ = 0; r_ < REP_UP; ++r_) {
                pg8::Gemm g{XBc, WUP, 68 * 256, 2 * DFF, DM, 1}; pg8::Epi<3> E{ACT, DFF, nullptr, PEb, SSl + MROWS * 16, nullptr, nullptr, P.in[22] + (size_t)l * 3 * 2 * DFF, P.in[23] + (size_t)l * 2 * DFF, (PG8_LAS float*)(lds + 131072)};
                pg8::StaticOrder S; S.init(68 * 256, 2 * DFF, G, bid); pg8::gemm_phase<pg8::Epi<3>, pg8::StaticOrder, true, true>(lds, g, S, E); }
            GSYNC();
            GEMM(ACT, WDN, DM, DFF, 1, nullptr, 0, nullptr, SSl + 2 * MROWS * 16, XBc, XBc);
            GSYNC();
            GEMM(XBc, WPG, DM, DM, 2, nullptr, 0, SSl + 2 * MROWS * 16, SSl + 3 * MROWS * 16, XBn, XBc);
            GSYNC();
        }
    }
    TIDS
    for (int m = gw; m < MROWS; m += NGW) {
        f32x4* xr = (f32x4*)(X + (size_t)m * DM) + lane; const v2u* xb = (const v2u*)(XB1 + (size_t)m * DM) + lane;
        float t = SS[((size_t)12 * MROWS + m) * 16 + (lane & 15)]; t += __shfl_xor(t, 1); t += __shfl_xor(t, 2); t += __shfl_xor(t, 4); t += __shfl_xor(t, 8); const float rs = rsqrtf(t * (1.f / DM) + EPS);
#pragma unroll
        for (int j = 0; j < 4; ++j) { const f32x4 g4 = ((const f32x4*)P.in[28])[lane + 64 * j]; const v2u w = xb[64 * j]; const f32x4 xv = {bflo(w.x), bfhi(w.x), bflo(w.y), bfhi(w.y)}; xr[64 * j] = xv * rs * g4; }
    }
}

extern "C" void kernel_launch(void* const* d_in, const int* in_sizes, int n_in, void* d_out, int out_size, void* d_ws, size_t ws_size, hipStream_t stream) {
    static int grid = 0;
    if (grid == 0) {
        if (n_in != 29 || out_size != MROWS * DM || ws_size < WS_END) { fprintf(stderr, "kernel_launch: unexpected shapes: n_in %d out %d ws %zu (need %zu)\n", n_in, out_size, ws_size, (size_t)WS_END); grid = -1; return; }
        int dev = 0, cus = 0, per_cu = 0;
        hipGetDevice(&dev); hipDeviceGetAttribute(&cus, hipDeviceAttributeMultiprocessorCount, dev);
        if (hipFuncSetAttribute((const void*)mega_fwd, hipFuncAttributeMaxDynamicSharedMemorySize, LDS_BYTES) != hipSuccess) { fprintf(stderr, "kernel_launch: hipFuncSetAttribute failed\n"); grid = -1; return; }
        if (hipOccupancyMaxActiveBlocksPerMultiprocessor(&per_cu, (const void*)mega_fwd, NT, LDS_BYTES) != hipSuccess || per_cu < 1) { fprintf(stderr, "kernel_launch: occupancy query failed (%d)\n", per_cu); (void)hipGetLastError(); per_cu = 1; }
        grid = cus * 1;
    }
    if (grid < 0) return;
    if (hipMemsetAsync(d_ws, 0, 65536, stream) != hipSuccess) { fprintf(stderr, "kernel_launch: memset failed\n"); return; }
    Params p{};
    for (int i = 0; i < 29; ++i) p.in[i] = (const float*)d_in[i];
    p.out = (float*)d_out; p.ws = (unsigned char*)d_ws;
    void* args[] = {&p};
    hipError_t e = hipLaunchCooperativeKernel((const void*)mega_fwd, dim3(grid), dim3(NT), args, LDS_BYTES, stream);
    if (e != hipSuccess) fprintf(stderr, "cooperative launch failed: %s (grid %d)\n", hipGetErrorString(e), grid);
}
```

```cpp
#include <hip/hip_runtime.h>
#include <hip/hip_cooperative_groups.h>
#include <cstdio>
#include <cstdint>
namespace cg = cooperative_groups;
#ifndef REP_SYNC
#define REP_SYNC 0
#endif
#ifndef REP_UP
#define REP_UP 1
#endif
#ifndef REP_MIX
#define REP_MIX 1
#endif
#ifndef REP_ELT
#define REP_ELT 1
#endif
namespace pg8 {
#define PG8_LAS __attribute__((address_space(3)))
typedef unsigned short bf16_t;
typedef short bf16x8 __attribute__((ext_vector_type(8)));
typedef float f32x4 __attribute__((ext_vector_type(4)));
typedef unsigned u32x4 __attribute__((ext_vector_type(4)));
constexpr int BM = 256, BK = 64, HALF = 128, HTB = HALF * BK * 2  , STAGE_BYTES = 8 * HTB, NXCD = 8, WGM = 8;
__host__ __device__ __forceinline__ int lds_byte(int r, int c) { const int st = (r >> 4) * 2 + (c >> 5), rr = r & 15, cc = c & 31, ob = rr * 64 + cc * 2; return st * 1024 + (ob ^ (((ob >> 9) & 1) << 5)); }
__host__ __device__ __forceinline__ void stage_rc(int b, int& R, int& C) { const int st = b / 1024, sb = b % 1024, swz = sb ^ (((sb >> 9) & 1) << 5); R = (st >> 1) * 16 + swz / 64; C = (st & 1) * 32 + (swz % 64) / 2; }
__host__ __device__ __forceinline__ int perm32(int rho) { const int n = rho >> 4, i = rho & 15; return 8 * (i >> 2) + 4 * n + (i & 3); }
struct Unit { int pm, pn; };
struct Gemm { const bf16_t* A; const bf16_t* Bt; int M, N, K; int conv; };
__host__ __device__ __forceinline__ long conv_rowbase(int pm) { return (long)(pm / 17) * 4096 + 254 * (pm % 17) - 2; }
struct StaticOrder {
    int nM, nN, nwg, G, c;
    __host__ __device__ void init(int M, int N, int G_, int c_) { nM = M / BM; nN = N / BM; nwg = nM * nN; G = G_; c = c_; }
    __host__ __device__ bool next(int i, Unit& u) const {
        const long L = (long)i * G + c; if (L >= nwg) return false;
        int wgid = (int)L; { const int q = nwg / NXCD, r = nwg % NXCD, xcd = wgid % NXCD, off = wgid / NXCD; wgid = (xcd < r ? xcd * (q + 1) : r * (q + 1) + (xcd - r) * q) + off; }
        const int nig = WGM * nN, gid = wgid / nig, fm = gid * WGM, gsz = (nM - fm) < WGM ? (nM - fm) : WGM;
        u.pm = fm + ((wgid % nig) % gsz); u.pn = (wgid % nig) / gsz; return true;
    }
    __device__ __forceinline__ void a_ready(const Unit&) const {}
    __device__ __forceinline__ void done(const Unit&) const {}
};
__device__ __forceinline__ unsigned cvt_pk_bf16(float lo, float hi) { unsigned r; asm volatile("v_cvt_pk_bf16_f32 %0, %1, %2" : "=v"(r) : "v"(lo), "v"(hi)); return r; }
__device__ __forceinline__ float bf_lo(unsigned w) { return __uint_as_float(w << 16); }
__device__ __forceinline__ float bf_hi(unsigned w) { return __uint_as_float(w & 0xffff0000u); }
template <int mode> struct Epi {
    static constexpr bool PERM = true, AFTER_DRAIN = false;
    bf16_t* O; int ldc; const bf16_t* XBi; const bf16_t* PE; const float* SSin; float* SSout; bf16_t* XBo;
    const float* cw; const float* cb; PG8_LAS float* exch;
    __device__ __forceinline__ void operator()(f32x4 (&acc)[2][2][4][2], const Unit& u, int wr, int wc, int fr, int fq) const {
        if constexpr (mode == 3) { conv_epi(acc, u, wr, wc, fr, fq); return; }
        const int row0 = u.pm * BM + wr * 64 + fr, col0 = u.pn * BM + wc * 32 + 8 * fq;
        float rsv[2][4];
        if (mode != 1 && SSin) { f32x4 p4[2][4];
#pragma unroll
            for (int ai = 0; ai < 2; ++ai)
#pragma unroll
                for (int m = 0; m < 4; ++m) p4[ai][m] = *(const f32x4*)(SSin + (size_t)(row0 + ai * HALF + m * 16) * 16 + 4 * fq);
            __builtin_amdgcn_sched_barrier(0);
#pragma unroll
            for (int ai = 0; ai < 2; ++ai)
#pragma unroll
                for (int m = 0; m < 4; ++m) { float t = (p4[ai][m][0] + p4[ai][m][1]) + (p4[ai][m][2] + p4[ai][m][3]); t += __shfl_xor(t, 16); t += __shfl_xor(t, 32); rsv[ai][m] = rsqrtf(t * (1.f / 1024.f) + 1e-6f); }
        } else {
#pragma unroll
            for (int ai = 0; ai < 2; ++ai)
#pragma unroll
                for (int m = 0; m < 4; ++m) rsv[ai][m] = 1.f;
        }
        if (mode == 0) {
#pragma unroll
            for (int ai = 0; ai < 2; ++ai)
#pragma unroll
                for (int m = 0; m < 4; ++m) { const float rs = rsv[ai][m]; bf16_t* rowp = O + (size_t)(row0 + ai * HALF + m * 16) * ldc + col0;
#pragma unroll
                    for (int bj = 0; bj < 2; ++bj) { const f32x4 v0 = acc[ai][bj][m][0] * rs, v1 = acc[ai][bj][m][1] * rs;
                        u32x4 w; w.x = cvt_pk_bf16(v0[0], v0[1]); w.y = cvt_pk_bf16(v0[2], v0[3]); w.z = cvt_pk_bf16(v1[0], v1[1]); w.w = cvt_pk_bf16(v1[2], v1[3]);
                        *(u32x4*)(rowp + bj * HALF) = w; } }
        } else {
#pragma unroll
            for (int ab = 0; ab < 4; ++ab) { const int ai = ab >> 1, mb = (ab & 1) * 2;
                u32x4 xi[2][2], pe[2][2];
#pragma unroll
                for (int mm = 0; mm < 2; ++mm)
#pragma unroll
                    for (int bj = 0; bj < 2; ++bj) { const size_t off = (size_t)(row0 + ai * HALF + (mb + mm) * 16) * 1024 + col0 + bj * HALF;
                        xi[mm][bj] = *(const u32x4*)(XBi + off); if (mode == 2) pe[mm][bj] = *(const u32x4*)(PE + off); }
                __builtin_amdgcn_sched_barrier(0);
#pragma unroll
                for (int mm = 0; mm < 2; ++mm) { const int m = mb + mm; const int row = row0 + ai * HALF + m * 16; const size_t off = (size_t)row * 1024 + col0; const float rs = rsv[ai][m]; float ss = 0.f;
#pragma unroll
                    for (int bj = 0; bj < 2; ++bj) { const u32x4 x4 = xi[mm][bj];
                        const f32x4 a = {bf_lo(x4.x), bf_hi(x4.x), bf_lo(x4.y), bf_hi(x4.y)}, b = {bf_lo(x4.z), bf_hi(x4.z), bf_lo(x4.w), bf_hi(x4.w)}; f32x4 x0, x1;
                        if (mode == 1) { x0 = a + acc[ai][bj][m][0]; x1 = b + acc[ai][bj][m][1]; }
                        else { const u32x4 p4 = pe[mm][bj]; const f32x4 v0 = acc[ai][bj][m][0] * rs, v1 = acc[ai][bj][m][1] * rs; f32x4 s0, s1;
#pragma unroll
                            for (int j = 0; j < 4; ++j) { s0[j] = __builtin_amdgcn_rcpf(1.f + __builtin_amdgcn_exp2f(-1.4426950408889634f * v0[j])); s1[j] = __builtin_amdgcn_rcpf(1.f + __builtin_amdgcn_exp2f(-1.4426950408889634f * v1[j])); }
                            const f32x4 e0 = {bf_lo(p4.x), bf_hi(p4.x), bf_lo(p4.y), bf_hi(p4.y)}, e1 = {bf_lo(p4.z), bf_hi(p4.z), bf_lo(p4.w), bf_hi(p4.w)};
                            x0 = a + e0 * s0; x1 = b + e1 * s1; }
                        u32x4 w; w.x = cvt_pk_bf16(x0[0], x0[1]); w.y = cvt_pk_bf16(x0[2], x0[3]); w.z = cvt_pk_bf16(x1[0], x1[1]); w.w = cvt_pk_bf16(x1[2], x1[3]);
                        *(u32x4*)(XBo + off + bj * HALF) = w;
                        ss += (x0[0] * x0[0] + x0[1] * x0[1]) + (x0[2] * x0[2] + x0[3] * x0[3]) + (x1[0] * x1[0] + x1[1] * x1[1]) + (x1[2] * x1[2] + x1[3] * x1[3]); }
                    ss += __shfl_xor(ss, 16); ss += __shfl_xor(ss, 32);
                    if (fq == 0) SSout[(size_t)row * 16 + u.pn * 4 + wc] = ss;
                }
            }
        }
    }

    static __device__ __forceinline__ float dpp_shr1(float oldv, float src) { return __int_as_float(__builtin_amdgcn_update_dpp(__float_as_int(oldv), __float_as_int(src), 0x111, 0xf, 0xf, false)); }
    static __device__ __forceinline__ float dpp_shr2(float oldv, float src) { return __int_as_float(__builtin_amdgcn_update_dpp(__float_as_int(oldv), __float_as_int(src), 0x112, 0xf, 0xf, false)); }
    static __device__ __forceinline__ float dpp_ror1(float src) { return __int_as_float(__builtin_amdgcn_update_dpp(0, __float_as_int(src), 0x121, 0xf, 0xf, false)); }
    static __device__ __forceinline__ float dpp_ror2(float src) { return __int_as_float(__builtin_amdgcn_update_dpp(0, __float_as_int(src), 0x122, 0xf, 0xf, false)); }
    __device__ __forceinline__ void conv_epi(f32x4 (&acc)[2][2][4][2], const Unit& u, int wr, int wc, int fr, int fq) const {
        const int bq = u.pm / 17, jt = u.pm % 17, tp0 = 254 * jt - 2 + wr * 64 + 4 * fr;
        const int wave = wr * 4 + wc;
        PG8_LAS float* wl = exch + 2048;
        { typedef float f32x2e __attribute__((ext_vector_type(2))); const int idx = (wave * 64 + fq * 16 + fr) * 2, kind = idx >> 7, ch = idx & 127;
          const float* src = ((kind & 3) < 3 ? cw + (kind & 3) * 5632 : cb) + (kind >> 2) * 2816 + u.pn * 128 + ch;
          *(PG8_LAS f32x2e*)(wl + idx) = *(const f32x2e*)src; }
        f32x4 pq[2][4];
#pragma unroll
        for (int ai = 0; ai < 2; ++ai)
#pragma unroll
            for (int m = 0; m < 4; ++m) pq[ai][m] = *(const f32x4*)(SSin + ((long)bq * 4096 + tp0 + ai * HALF + m) * 16 + 4 * fq);
        __builtin_amdgcn_sched_barrier(0);
#pragma unroll
        for (int ai = 0; ai < 2; ++ai)
#pragma unroll
            for (int m = 0; m < 4; ++m) { const int tp = tp0 + ai * HALF + m;
                const f32x4 p4 = pq[ai][m]; float t = (p4[0] + p4[1]) + (p4[2] + p4[3]); t += __shfl_xor(t, 16); t += __shfl_xor(t, 32);
                const float rs = rsqrtf(t * (1.f / 1024.f) + 1e-6f);
                if (ai == 0 && m < 2 && jt == 0 && wr == 0) {
#pragma unroll
                    for (int bj = 0; bj < 2; ++bj)
#pragma unroll
                        for (int n = 0; n < 2; ++n)
#pragma unroll
                            for (int j = 0; j < 4; ++j) acc[ai][bj][m][n][j] = (tp >= 0) ? acc[ai][bj][m][n][j] * rs : 0.f;
                } else {
#pragma unroll
                    for (int bj = 0; bj < 2; ++bj) { acc[ai][bj][m][0] *= rs; acc[ai][bj][m][1] *= rs; }
                } }
        if (fr == 15) {
#pragma unroll
            for (int ai = 0; ai < 2; ++ai)
#pragma unroll
                for (int bj = 0; bj < 2; ++bj)
#pragma unroll
                    for (int n = 0; n < 2; ++n)
#pragma unroll
                        for (int j = 0; j < 4; ++j) { typedef float f32x2e __attribute__((ext_vector_type(2)));
                            *(PG8_LAS f32x2e*)(exch + ((wave * 2 + ai) * 16 + bj * 8 + n * 4 + j) * 8 + fq * 2) = (f32x2e){acc[ai][bj][2][n][j], acc[ai][bj][3][n][j]}; }
        }
        asm volatile("s_waitcnt lgkmcnt(0)" ::: "memory"); __builtin_amdgcn_s_barrier(); asm volatile("" ::: "memory");
        const int cch = u.pn * 128 + wc * 32 + 8 * fq;
#pragma unroll
        for (int ai = 0; ai < 2; ++ai) {
            const bool has_prev = (wr == 1) || (ai == 1);
            const int pw = (wr == 1 ? 0 : 4) + wc, pai = (wr == 1) ? ai : 0;
            unsigned ow[4][4];
#pragma unroll
            for (int n = 0; n < 2; ++n)
#pragma unroll
                for (int jp = 0; jp < 2; ++jp) {
                    float o[4][2];
#pragma unroll
                    for (int jj = 0; jj < 2; ++jj) {
                        const int j = 2 * jp + jj; const PG8_LAS float* wc_ = wl + wc * 32 + 8 * fq + 4 * n + j;
                        const float wg0 = wc_[0], wg1 = wc_[128], wg2 = wc_[256], bg = wc_[384], wv0 = wc_[512], wv1 = wc_[640], wv2 = wc_[768], bv = wc_[896];
                        float pg2 = 0.f, pg3 = 0.f, pv2 = 0.f, pv3 = 0.f;
                        if (has_prev) { typedef float f32x2e __attribute__((ext_vector_type(2)));
                            const f32x2e a = *(const PG8_LAS f32x2e*)(exch + ((pw * 2 + pai) * 16 + n * 4 + j) * 8 + fq * 2), b = *(const PG8_LAS f32x2e*)(exch + ((pw * 2 + pai) * 16 + 8 + n * 4 + j) * 8 + fq * 2);
                            pg2 = a.x; pg3 = a.y; pv2 = b.x; pv3 = b.y; }
                        const float G0 = acc[ai][0][0][n][j], G1 = acc[ai][0][1][n][j], G2 = acc[ai][0][2][n][j], G3 = acc[ai][0][3][n][j];
                        const float V0 = acc[ai][1][0][n][j], V1 = acc[ai][1][1][n][j], V2 = acc[ai][1][2][n][j], V3 = acc[ai][1][3][n][j];
                        const float Gm1 = dpp_shr1(pg3, G3), Gm2 = dpp_shr1(pg2, G2), Vm1 = dpp_shr1(pv3, V3), Vm2 = dpp_shr1(pv2, V2);
                        const float cg[4] = {bg + wg0 * Gm2 + wg1 * Gm1 + wg2 * G0, bg + wg0 * Gm1 + wg1 * G0 + wg2 * G1, bg + wg0 * G0 + wg1 * G1 + wg2 * G2, bg + wg0 * G1 + wg1 * G2 + wg2 * G3};
                        const float cv[4] = {bv + wv0 * Vm2 + wv1 * Vm1 + wv2 * V0, bv + wv0 * Vm1 + wv1 * V0 + wv2 * V1, bv + wv0 * V0 + wv1 * V1 + wv2 * V2, bv + wv0 * V1 + wv1 * V2 + wv2 * V3};
#pragma unroll
                        for (int m = 0; m < 4; ++m) { o[m][jj] = cg[m] * __builtin_amdgcn_rcpf(1.f + __builtin_amdgcn_exp2f(cg[m] * (-2.3022081980f + -0.1029432398f * (cg[m] * cg[m])))) * cv[m]; }
                    }
#pragma unroll
                    for (int m = 0; m < 4; ++m) ow[m][2 * n + jp] = cvt_pk_bf16(o[m][0], o[m][1]);
                    asm volatile("" ::: "memory");
                }
#pragma unroll
            for (int m = 0; m < 4; ++m) { const int r = ai * HALF + wr * 64 + 4 * fr + m, tp = tp0 + ai * HALF + m;
                if (r >= 2 && tp < 4096) { u32x4 w; w.x = ow[m][0]; w.y = ow[m][1]; w.z = ow[m][2]; w.w = ow[m][3]; *(u32x4*)(O + ((size_t)bq * 4096 + tp) * 2816 + cch) = w; } }
        }
    }

};
template <class Epi, class Sched, bool ALIGN_EPI = false, bool SP2 = false>
__device__ __forceinline__ void gemm_phase(PG8_LAS unsigned char* lds, const Gemm g, const Sched& S, const Epi& E) {
    int tid_ = threadIdx.x; asm volatile("" : "+v"(tid_)); const int tid = tid_, wid = __builtin_amdgcn_readfirstlane(tid >> 6), lane = tid & 63, wr = wid >> 2, wc = wid & 3, fr = lane & 15, fq = lane >> 4;
    const int K = g.K, nt = K / BK;
    unsigned voffA[2], voffB[2];
#pragma unroll
    for (int i = 0; i < 2; ++i) { int R, C; stage_rc(tid * 16 + i * 8192, R, C); const int Rb = Epi::PERM ? ((R & ~31) + perm32(R & 31)) : R;
        const int Ra = g.conv ? ((R & ~63) + 4 * (R & 15) + ((R >> 4) & 3)) : R;
        voffA[i] = (unsigned)(Ra * K + C) * 2u; voffB[i] = (unsigned)(Rb * K + C) * 2u; }
    const size_t kstep = (size_t)(BK * 2);
    const size_t hstep = (size_t)HALF * K * 2;
    const size_t tstep = 2 * hstep;
    const unsigned ldsw = (unsigned)wid * 1024u;
    const int aoff = lds_byte(wr * 64 + fr, fq * 8), boff = lds_byte(wc * 32 + fr, fq * 8);
#define PG8_SA(b, h) (((b) * 2 + (h)) * HTB)
#define PG8_SB(b, h) ((4 + (b) * 2 + (h)) * HTB)
#define PG8_STAGE(bufoff, gbase, voff) do { _Pragma("unroll") for (int _i = 0; _i < 2; ++_i) \
        __builtin_amdgcn_global_load_lds((const unsigned*)((const char*)(gbase) + (voff)[_i]), (PG8_LAS unsigned*)(lds + (bufoff) + ldsw + _i * 8192), 16, 0, 0); } while (0)
#define PG8_LDA(dst, b, h) do { _Pragma("unroll") for (int m = 0; m < 4; ++m) _Pragma("unroll") for (int k = 0; k < 2; ++k) dst[m][k] = *(const PG8_LAS bf16x8*)(lds + PG8_SA(b, h) + aoff + m * 2048 + k * 1024); } while (0)
#define PG8_LDB(dst, b, h) do { _Pragma("unroll") for (int n = 0; n < 2; ++n) _Pragma("unroll") for (int k = 0; k < 2; ++k) dst[n][k] = *(const PG8_LAS bf16x8*)(lds + PG8_SB(b, h) + boff + n * 2048 + k * 1024); } while (0)
#define PG8_MMA(ai, bj, At, Bt) do { __builtin_amdgcn_s_setprio(1); _Pragma("unroll") for (int m = 0; m < 4; ++m) _Pragma("unroll") for (int n = 0; n < 2; ++n) _Pragma("unroll") for (int k = 0; k < 2; ++k) \
        acc[ai][bj][m][n] = __builtin_amdgcn_mfma_f32_16x16x32_bf16(Bt[n][k], At[m][k], acc[ai][bj][m][n], 0, 0, 0); __builtin_amdgcn_s_setprio(0); } while (0)
#define PG8_WAIT_V(n) asm volatile("s_waitcnt vmcnt(" #n ")" ::: "memory")
#define PG8_WAIT_L(n) asm volatile("s_waitcnt lgkmcnt(" #n ")" ::: "memory")
#define PG8_BAR __builtin_amdgcn_s_barrier()
#define PG8_SCHED __builtin_amdgcn_sched_barrier(0)
    Unit cur, nxt; int ui = 0;
    if (!S.next(0, cur)) return;
    f32x4 acc[2][2][4][2];
#pragma unroll
    for (int a = 0; a < 2; ++a)
#pragma unroll
        for (int b = 0; b < 2; ++b)
#pragma unroll
            for (int m = 0; m < 4; ++m)
#pragma unroll
                for (int n = 0; n < 2; ++n) acc[a][b][m][n] = (f32x4){0.f, 0.f, 0.f, 0.f};
    bf16x8 At[4][2], B0[2][2], B1[2][2];
    const char* cA = (const char*)g.A + (g.conv ? (size_t)(conv_rowbase(cur.pm) * (long)(K * 2)) : (size_t)cur.pm * tstep); const char* cB = (const char*)g.Bt + (size_t)cur.pn * tstep;
    S.a_ready(cur);
    if constexpr (SP2) {
        PG8_STAGE(PG8_SB(0, 0), cB, voffB); PG8_STAGE(PG8_SB(0, 1), cB + hstep, voffB); PG8_STAGE(PG8_SA(0, 0), cA, voffA); PG8_STAGE(PG8_SA(0, 1), cA + hstep, voffA);
        if (wr == 1) PG8_BAR;
        PG8_WAIT_V(2); PG8_BAR;
        PG8_STAGE(PG8_SB(1, 0), cB + kstep, voffB); PG8_STAGE(PG8_SA(1, 0), cA + kstep, voffA); PG8_STAGE(PG8_SB(1, 1), cB + hstep + kstep, voffB);
        PG8_WAIT_V(6); PG8_BAR;
    } else {
        PG8_STAGE(PG8_SB(0, 0), cB, voffB); PG8_STAGE(PG8_SA(0, 0), cA, voffA); PG8_STAGE(PG8_SB(0, 1), cB + hstep, voffB); PG8_STAGE(PG8_SA(0, 1), cA + hstep, voffA);
        if (wr == 1) PG8_BAR;
        PG8_WAIT_V(4); PG8_BAR;
        PG8_STAGE(PG8_SB(1, 0), cB + kstep, voffB); PG8_STAGE(PG8_SA(1, 0), cA + kstep, voffA); PG8_STAGE(PG8_SB(1, 1), cB + hstep + kstep, voffB);
        PG8_WAIT_V(6); PG8_BAR;
    }
    for (;;) {
        const bool has_next = S.next(ui + 1, nxt);
        const char* nA = has_next ? (const char*)g.A + (g.conv ? (size_t)(conv_rowbase(nxt.pm) * (long)(K * 2)) : (size_t)nxt.pm * tstep) : cA; const char* nB = has_next ? (const char*)g.Bt + (size_t)nxt.pn * tstep : cB;
        for (int t = 0; t < nt; t += 2) {
            const bool last = (t == nt - 2);
            const char* a1 = cA + (size_t)(t + 1) * kstep;
            const char* a2 = last ? nA : cA + (size_t)(t + 2) * kstep; const char* b2 = last ? nB : cB + (size_t)(t + 2) * kstep;
            const char* a3 = a2 + kstep; const char* b3 = b2 + kstep;
            if (last && has_next) S.a_ready(nxt);
            if constexpr (SP2) {
            PG8_LDB(B0, 0, 0); PG8_LDB(B1, 0, 1); PG8_SCHED; PG8_LDA(At, 0, 0); PG8_STAGE(PG8_SA(1, 1), a1 + hstep, voffA);
            PG8_WAIT_V(8); PG8_WAIT_L(0); PG8_BAR; PG8_MMA(0, 0, At, B0); PG8_MMA(0, 1, At, B1); PG8_BAR; PG8_SCHED;
            PG8_LDA(At, 0, 1); PG8_STAGE(PG8_SB(0, 0), b2, voffB); PG8_STAGE(PG8_SB(0, 1), b2 + hstep, voffB); PG8_STAGE(PG8_SA(0, 0), a2, voffA);
            PG8_WAIT_V(8); PG8_WAIT_L(0); PG8_BAR; PG8_MMA(1, 0, At, B0); PG8_MMA(1, 1, At, B1); PG8_BAR; PG8_SCHED;
            PG8_LDB(B0, 1, 0); PG8_LDB(B1, 1, 1); PG8_SCHED; PG8_LDA(At, 1, 0); PG8_STAGE(PG8_SA(0, 1), a2 + hstep, voffA);
            PG8_WAIT_V(8); PG8_WAIT_L(0); PG8_BAR; PG8_MMA(0, 0, At, B0); PG8_MMA(0, 1, At, B1); PG8_BAR; PG8_SCHED;
            PG8_LDA(At, 1, 1); PG8_STAGE(PG8_SB(1, 0), b3, voffB); PG8_STAGE(PG8_SB(1, 1), b3 + hstep, voffB); PG8_STAGE(PG8_SA(1, 0), a3, voffA);
            PG8_WAIT_V(8); PG8_WAIT_L(0); PG8_BAR; PG8_MMA(1, 0, At, B0); PG8_MMA(1, 1, At, B1); PG8_BAR; PG8_SCHED;
            } else {
            PG8_LDB(B0, 0, 0); PG8_SCHED; PG8_LDA(At, 0, 0); PG8_STAGE(PG8_SA(1, 1), a1 + hstep, voffA);
            PG8_WAIT_L(8); PG8_BAR; PG8_WAIT_L(0); PG8_MMA(0, 0, At, B0); PG8_BAR; PG8_SCHED;
            PG8_LDB(B1, 0, 1); PG8_STAGE(PG8_SB(0, 0), b2, voffB);
            PG8_BAR; PG8_WAIT_L(0); PG8_MMA(0, 1, At, B1); PG8_BAR;
            PG8_LDA(At, 0, 1); PG8_STAGE(PG8_SA(0, 0), a2, voffA);
            PG8_BAR; PG8_WAIT_L(0); PG8_MMA(1, 0, At, B0); PG8_BAR; PG8_SCHED;
            PG8_STAGE(PG8_SB(0, 1), b2 + hstep, voffB);
            PG8_WAIT_V(6); PG8_BAR; PG8_MMA(1, 1, At, B1); PG8_BAR;
            PG8_LDB(B0, 1, 0); PG8_SCHED; PG8_LDA(At, 1, 0); PG8_STAGE(PG8_SA(0, 1), a2 + hstep, voffA);
            PG8_WAIT_L(8); PG8_BAR; PG8_WAIT_L(0); PG8_MMA(0, 0, At, B0); PG8_BAR; PG8_SCHED;
            PG8_LDB(B1, 1, 1); PG8_STAGE(PG8_SB(1, 0), b3, voffB);
            PG8_BAR; PG8_WAIT_L(0); PG8_MMA(0, 1, At, B1); PG8_BAR;
            PG8_LDA(At, 1, 1); PG8_STAGE(PG8_SA(1, 0), a3, voffA);
            PG8_BAR; PG8_WAIT_L(0); PG8_MMA(1, 0, At, B0); PG8_BAR; PG8_SCHED;
            PG8_STAGE(PG8_SB(1, 1), b3 + hstep, voffB);
            PG8_WAIT_V(6); PG8_BAR; PG8_MMA(1, 1, At, B1); PG8_BAR;
            }
        }
        if constexpr (ALIGN_EPI) { if (wr == 0) PG8_BAR; }
        if constexpr (!Epi::AFTER_DRAIN) { E(acc, cur, wr, wc, fr, fq); S.done(cur); }
        if (!has_next) break;
#pragma unroll
        for (int a = 0; a < 2; ++a)
#pragma unroll
            for (int b = 0; b < 2; ++b)
#pragma unroll
                for (int m = 0; m < 4; ++m)
#pragma unroll
                    for (int n = 0; n < 2; ++n) acc[a][b][m][n] = (f32x4){0.f, 0.f, 0.f, 0.f};
        cur = nxt; cA = nA; cB = nB; ++ui;
        if constexpr (ALIGN_EPI) { if (wr == 1) PG8_BAR; }
    }
    PG8_WAIT_V(0);
    if constexpr (!ALIGN_EPI) { if (wr == 0) PG8_BAR; }
    PG8_BAR;
    if constexpr (Epi::AFTER_DRAIN) { E.fused(acc, cur, wr, wc, fr, fq, lds, wid, lane); S.done(cur); }
#undef PG8_SA
#undef PG8_SB
#undef PG8_STAGE
#undef PG8_LDA
#undef PG8_LDB
#undef PG8_MMA
#undef PG8_WAIT_V
#undef PG8_WAIT_L
#undef PG8_BAR
#undef PG8_SCHED
}
}

#define LAS __attribute__((address_space(3)))
typedef unsigned short bf16_t;
typedef unsigned v4u __attribute__((ext_vector_type(4)));
typedef unsigned v2u __attribute__((ext_vector_type(2)));
typedef float f32x4 __attribute__((ext_vector_type(4)));
constexpr int NT = 512, NWAVES = 8;
constexpr int BATCH = 4, SEQ = 4096, DM = 1024, MROWS = BATCH * SEQ, DPROJ = 2304, DFF = 2816, PLE = 256, DEPTH = 4;
constexpr float EPS = 1e-6f;
constexpr int LDS_BYTES = 147456;
constexpr size_t MiB = 1u << 20;
constexpr size_t WS_WIN = 1 * MiB, WS_WOUT = 6 * MiB, WS_WUP = 8 * MiB, WS_WDN = 19 * MiB, WS_WPG = 25 * MiB, WS_WPE = 27 * MiB;
constexpr size_t WS_RGA = 28 * MiB, WS_RGH = 28 * MiB + 512 * 1024, WS_CARRY = 29 * MiB, WS_DEC = 30 * MiB;
constexpr size_t WS_H = 32 * MiB, WS_PBF = 64 * MiB, WS_ACT = 160 * MiB  , WS_HF = 160 * MiB;
constexpr size_t WS_Z = 160 * MiB, WS_MIX = 232 * MiB, WS_ST = 264 * MiB, WS_HL = 280 * MiB, WS_CA = 288 * MiB;
constexpr size_t WS_WSM = 27 * MiB + 512 * 1024, WS_WAT = WS_WSM + 128 * 1024, WS_WXT = WS_WAT + 32 * 1024, WS_WDT = WS_WXT + 32 * 1024, WS_STB = 296 * MiB;
constexpr size_t WS_SS = 336 * MiB, WS_XB1 = 304 * MiB;
constexpr size_t WS_PE = 72 * MiB;
constexpr size_t WS_END = 349 * MiB;

__device__ __forceinline__ float bf2f(bf16_t v) { return __uint_as_float(((unsigned)v) << 16); }
__device__ __forceinline__ float bflo(unsigned w) { return __uint_as_float(w << 16); }
__device__ __forceinline__ float bfhi(unsigned w) { return __uint_as_float(w & 0xffff0000u); }
__device__ __forceinline__ unsigned pk2(float lo, float hi) { unsigned r; asm("v_cvt_pk_bf16_f32 %0, %1, %2" : "=v"(r) : "v"(lo), "v"(hi)); return r; }
__device__ __forceinline__ unsigned f2bf(float f) { return pk2(f, f) & 0xffffu; }
__device__ __forceinline__ float frcp(float x) { return __builtin_amdgcn_rcpf(x); }
__device__ __forceinline__ float sigm(float x) { return frcp(1.f + __builtin_amdgcn_exp2f(-1.4426950408889634f * x)); }
__device__ __forceinline__ float gelu_t(float x) { return x * frcp(1.f + __builtin_amdgcn_exp2f(x * (-2.3022081980f + -0.1029432398f * (x * x)))); }
__device__ __forceinline__ float silu_(float x) { return x * frcp(1.f + __builtin_amdgcn_exp2f(-1.4426950408889634f * x)); }
__device__ __forceinline__ float wave_sum(float v) {
#pragma unroll
    for (int o = 1; o < 64; o <<= 1) v += __shfl_xor(v, o);
    return v;
}
#define LDS_WAIT() asm volatile("s_waitcnt lgkmcnt(0)" ::: "memory")

struct Params { const float* in[29]; float* out; unsigned char* ws; };

__device__ __forceinline__ void transpose_item(const float* W, int K, int N, bf16_t* WT, LAS float* scr, int item, int lane, const float* gk, bool ffn_perm = false) {
    const int nblk = N / 32, kb = item / nblk, nb = item % nblk, k0 = 64 * kb, n0 = 32 * nb;
    float wreg[32];
#pragma unroll
    for (int i = 0; i < 32; ++i) wreg[i] = __builtin_nontemporal_load(&W[(size_t)(k0 + 2 * i + (lane >> 5)) * N + n0 + (lane & 31)]);
#pragma unroll
    for (int i = 0; i < 32; ++i) scr[(2 * i + (lane >> 5)) * 33 + (lane & 31)] = wreg[i];
    LDS_WAIT(); asm volatile("" ::: "memory");
    const int c = lane & 7;
#pragma unroll
    for (int j = 0; j < 4; ++j) { const int n = (lane >> 3) + 8 * j; const LAS float* s = scr + (8 * c) * 33 + n;
        f32x4 ga = {1.f, 1.f, 1.f, 1.f}, gb = {1.f, 1.f, 1.f, 1.f}; if (gk) { ga = *(const f32x4*)(gk + k0 + 8 * c); gb = *(const f32x4*)(gk + k0 + 8 * c + 4); }
        v4u o; o.x = pk2(s[0 * 33] * ga.x, s[1 * 33] * ga.y); o.y = pk2(s[2 * 33] * ga.z, s[3 * 33] * ga.w); o.z = pk2(s[4 * 33] * gb.x, s[5 * 33] * gb.y); o.w = pk2(s[6 * 33] * gb.z, s[7 * 33] * gb.w);
        int nr = n0 + n; if (ffn_perm) { const int hv = nr / DFF, cc = nr % DFF; nr = (cc >> 7) * 256 + hv * 128 + (cc & 127); }
        *(v4u*)(WT + (size_t)nr * K + k0 + 8 * c) = o; }
    LDS_WAIT(); asm volatile("" ::: "memory");
}

typedef short bf16x8 __attribute__((ext_vector_type(8)));
#define MFMA16(a, b, c) __builtin_amdgcn_mfma_f32_16x16x32_bf16((a), (b), (c), 0, 0, 0)
__device__ __forceinline__ bf16x8 ldsfrag(const LAS bf16_t* base, int row, int pitch, int k) { return *(const LAS bf16x8*)(base + row * pitch + k); }

__device__ __forceinline__ void gmlp2_unit(const Params& P, int l, int unit, LAS unsigned char* lds, int tid) {
    const int lane = tid & 63, wave = __builtin_amdgcn_readfirstlane(tid >> 6), lr = lane & 15, lq = lane >> 4;
    const int hp = unit & 1, n = (unit >> 1) & 31, b = unit >> 6; const size_t row0 = (size_t)b * SEQ + n * 128;
    LAS bf16_t* vnT = (LAS bf16_t*)lds;
    const bf16_t* Z = (const bf16_t*)(P.ws + WS_Z); bf16_t* MIX = (bf16_t*)(P.ws + WS_MIX); const bf16_t* WSM = (const bf16_t*)(P.ws + WS_WSM);
    const float* bs = P.in[7] + l * 4 * 128;
    {
        const f32x4 g4 = ((const f32x4*)(P.in[4] + l * 256))[lane], b4 = ((const f32x4*)(P.in[5] + l * 256))[lane];
        v2u raw[16];
#pragma unroll
        for (int tt = 0; tt < 16; ++tt) raw[tt] = *(const v2u*)(Z + (row0 + wave * 16 + tt) * DPROJ + 256 + lane * 4);
        __builtin_amdgcn_sched_barrier(0);
        unsigned pk[4][8];
#pragma unroll
        for (int hb = 0; hb < 2; ++hb) {
            float s1[8], s2[8];
#pragma unroll
            for (int t8 = 0; t8 < 8; ++t8) { const int tt = hb * 8 + t8; const float v0 = gelu_t(bflo(raw[tt].x)), v1 = gelu_t(bfhi(raw[tt].x)), v2 = gelu_t(bflo(raw[tt].y)), v3 = gelu_t(bfhi(raw[tt].y));
                raw[tt].x = pk2(v0, v1); raw[tt].y = pk2(v2, v3);
                const float w0 = bflo(raw[tt].x), w1 = bfhi(raw[tt].x), w2 = bflo(raw[tt].y), w3 = bfhi(raw[tt].y);
                s1[t8] = (w0 + w1) + (w2 + w3); s2[t8] = (w0 * w0 + w1 * w1) + (w2 * w2 + w3 * w3); }
#pragma unroll
            for (int o = 1; o < 64; o <<= 1) {
#pragma unroll
                for (int t8 = 0; t8 < 8; ++t8) { s1[t8] += __shfl_xor(s1[t8], o); s2[t8] += __shfl_xor(s2[t8], o); } }
#pragma unroll
            for (int t8 = 0; t8 < 8; ++t8) { const int tt = hb * 8 + t8;
                const float mu = s1[t8] * (1.f / 256.f); const float var = fmaxf(s2[t8] * (1.f / 256.f) - mu * mu, 0.f); const float rstd = rsqrtf(var + EPS);
                const float v0 = bflo(raw[tt].x) - mu, v1 = bfhi(raw[tt].x) - mu, v2 = bflo(raw[tt].y) - mu, v3 = bfhi(raw[tt].y) - mu;
                const unsigned o0 = f2bf(v0 * rstd * g4.x + b4.x), o1 = f2bf(v1 * rstd * g4.y + b4.y), o2 = f2bf(v2 * rstd * g4.z + b4.z), o3 = f2bf(v3 * rstd * g4.w + b4.w);
                if (tt & 1) { pk[0][tt >> 1] |= o0 << 16; pk[1][tt >> 1] |= o1 << 16; pk[2][tt >> 1] |= o2 << 16; pk[3][tt >> 1] |= o3 << 16; }
                else { pk[0][tt >> 1] = o0; pk[1][tt >> 1] = o1; pk[2][tt >> 1] = o2; pk[3][tt >> 1] = o3; }
            }
            asm volatile("" ::: "memory");
        }
        if ((lane >> 5) == hp) {
#pragma unroll
            for (int i = 0; i < 4; ++i) { LAS v4u* dst = (LAS v4u*)(vnT + ((lane & 31) * 4 + i) * 136 + wave * 16);
                dst[0] = (v4u){pk[i][0], pk[i][1], pk[i][2], pk[i][3]}; dst[1] = (v4u){pk[i][4], pk[i][5], pk[i][6], pk[i][7]}; }
        }
    }
    __syncthreads();
    const int t0 = wave * 16, nks = (wave >> 1) + 1;
#pragma unroll
    for (int hl = 0; hl < 2; ++hl) {
        const int h = hp * 2 + hl;
        f32x4 acc[4];
#pragma unroll
        for (int nt = 0; nt < 4; ++nt) acc[nt] = (f32x4){0.f, 0.f, 0.f, 0.f};
        float uu[4][4];
#pragma unroll
        for (int nt = 0; nt < 4; ++nt)
#pragma unroll
            for (int jj = 0; jj < 4; ++jj) uu[nt][jj] = bf2f(Z[(row0 + t0 + lq * 4 + jj) * DPROJ + h * 64 + nt * 16 + lr]);
        float bsv4[4];
#pragma unroll
        for (int jj = 0; jj < 4; ++jj) bsv4[jj] = bs[h * 128 + t0 + lq * 4 + jj];
        bf16x8 af[4];
#pragma unroll
        for (int ks = 0; ks < 4; ++ks) af[ks] = *(const bf16x8*)(WSM + ((size_t)(h * 128 + t0 + lr)) * 128 + (ks < nks ? ks : 0) * 32 + lq * 8);
        __builtin_amdgcn_sched_barrier(0);
#pragma unroll
        for (int ks = 0; ks < 4; ++ks) if (ks < nks) {
#pragma unroll
            for (int nt = 0; nt < 4; ++nt) acc[nt] = MFMA16(af[ks], ldsfrag(vnT, hl * 64 + nt * 16 + lr, 136, ks * 32 + lq * 8), acc[nt]);
        }
#pragma unroll
        for (int jj = 0; jj < 4; ++jj) { const int t = t0 + lq * 4 + jj; const float bsv = bsv4[jj];
#pragma unroll
            for (int nt = 0; nt < 4; ++nt) MIX[(row0 + t) * DM + h * 64 + nt * 16 + lr] = (bf16_t)f2bf(gelu_t(uu[nt][jj]) * (acc[nt][jj] + bsv)); }
    }
    __syncthreads();
}

__device__ __forceinline__ void pool2_unit(const Params& P, int l, int unit, LAS unsigned char* lds, int tid) {
    const int lane = tid & 63, wave = __builtin_amdgcn_readfirstlane(tid >> 6), lr = lane & 15, lq = lane >> 4;
    const int b = unit >> 6, n = unit & 63; const size_t row0 = (size_t)b * SEQ + n * 64;
    LAS float* raw = (LAS float*)lds;
    LAS bf16_t* plB = (LAS bf16_t*)(lds + 79 * 256 * 4);
    const bf16_t* Z = (const bf16_t*)(P.ws + WS_Z); bf16_t* MIX = (bf16_t*)(P.ws + WS_MIX); const bf16_t* WDT = (const bf16_t*)(P.ws + WS_WDT);
    { const int c = tid & 255, half = tid >> 8; bf16_t rv[40];
      const bf16_t* zc = Z + ((size_t)b * SEQ) * DPROJ + 2048 + c;
#pragma unroll
      for (int i = 0; i < 40; ++i) { int r = half + 2 * i; r = r < 79 ? r : 78; int tp = n * 64 - 15 + r; tp = tp >= 0 ? tp : 0; rv[i] = zc[(size_t)tp * DPROJ]; }
      __builtin_amdgcn_sched_barrier(0);
#pragma unroll
      for (int i = 0; i < 40; ++i) { const int r = half + 2 * i; if (r < 79) raw[r * 256 + c] = (n * 64 - 15 + r >= 0) ? bf2f(rv[i]) : 0.f; } }
    __syncthreads();
    { const int c = tid & 255, half = tid >> 8, w = 2 << (c >> 6), tb = half * 32;
      float s = 0.f; for (int j = 1; j < w; ++j) s += raw[(15 + tb - j) * 256 + c];
#pragma unroll 8
      for (int i = 0; i < 32; ++i) { const int t = tb + i; const float cur = raw[(15 + t) * 256 + c]; s += cur;
          const int pos1 = n * 64 + t + 1; const float cnt = (float)(pos1 < w ? pos1 : w);
          plB[t * 264 + c] = (bf16_t)f2bf(s * frcp(cnt) - cur);
          s -= raw[(15 + t - w + 1) * 256 + c]; } }
    __syncthreads();
    const int g = wave >> 1, ntp = wave & 1;
    bf16x8 Bf[2][2];
#pragma unroll
    for (int n2 = 0; n2 < 2; ++n2)
#pragma unroll
        for (int ks = 0; ks < 2; ++ks) Bf[n2][ks] = *(const bf16x8*)(WDT + ((size_t)(g * 64 + (ntp * 2 + n2) * 16 + lr)) * 64 + ks * 32 + lq * 8);
    float sc[2];
#pragma unroll
    for (int n2 = 0; n2 < 2; ++n2) sc[n2] = P.in[18][l * 256 + g * 64 + (ntp * 2 + n2) * 16 + lr];
#pragma unroll
    for (int mt = 0; mt < 4; ++mt) {
        f32x4 acc[2] = {(f32x4){0.f, 0.f, 0.f, 0.f}, (f32x4){0.f, 0.f, 0.f, 0.f}};
#pragma unroll
        for (int ks = 0; ks < 2; ++ks) { const bf16x8 a = ldsfrag(plB, mt * 16 + lr, 264, g * 64 + ks * 32 + lq * 8);
#pragma unroll
            for (int n2 = 0; n2 < 2; ++n2) acc[n2] = MFMA16(a, Bf[n2][ks], acc[n2]); }
#pragma unroll
        for (int n2 = 0; n2 < 2; ++n2)
#pragma unroll
            for (int jj = 0; jj < 4; ++jj) MIX[(row0 + mt * 16 + lq * 4 + jj) * DM + 768 + g * 64 + (ntp * 2 + n2) * 16 + lr] = (bf16_t)f2bf(acc[n2][jj] * sc[n2]);
    }
    __syncthreads();
}

__device__ __forceinline__ void rglru2_unit(const Params& P, int l, int unit, LAS unsigned char* lds, int tid) {
    const int lane = tid & 63, wave = __builtin_amdgcn_readfirstlane(tid >> 6), lr = lane & 15, lq = lane >> 4;
    const int b = unit >> 6, k = unit & 63; const size_t row0 = (size_t)b * SEQ + k * 64;
    LAS float* xcF = (LAS float*)lds;
    LAS bf16_t* xcB = (LAS bf16_t*)(lds + 64 * 256 * 4);
    const bf16_t* Z = (const bf16_t*)(P.ws + WS_Z);
    bf16_t* HL = (bf16_t*)(P.ws + WS_HL); bf16_t* CA = (bf16_t*)(P.ws + WS_CA);
    float* RGA = (float*)(P.ws + WS_RGA); float* RGH = (float*)(P.ws + WS_RGH);
    const bf16_t* WAT = (const bf16_t*)(P.ws + WS_WAT); const bf16_t* WXT = (const bf16_t*)(P.ws + WS_WXT);
    {
        const int c = tid & 255, half = tid >> 8, tp0 = k * 64 + half * 32;
        const float* cwp = P.in[8] + (size_t)l * 4 * 256 + c;
        const float cw0 = cwp[0], cw1 = cwp[256], cw2 = cwp[512], cw3 = cwp[768], cb = P.in[9][l * 256 + c];
        const bf16_t* zb = Z + ((size_t)b * SEQ) * DPROJ + 512 + c;
        float xr[35];
#pragma unroll
        for (int i = 0; i < 35; ++i) { const int tp = tp0 - 3 + i; xr[i] = __uint_as_float((unsigned)zb[(size_t)(tp >= 0 ? tp : 0) * DPROJ] << 16); }
        __builtin_amdgcn_sched_barrier(0);
#pragma unroll
        for (int i = 0; i < 3; ++i) { asm volatile("" : "+v"(xr[i])); xr[i] = (tp0 - 3 + i >= 0) ? xr[i] : 0.f; }
#pragma unroll
        for (int tt = 0; tt < 32; ++tt) { const float xc = cb + cw0 * xr[tt] + cw1 * xr[tt + 1] + cw2 * xr[tt + 2] + cw3 * xr[tt + 3];
            xcF[(half * 32 + tt) * 256 + c] = xc; xcB[(half * 32 + tt) * 264 + c] = (bf16_t)f2bf(xc); }
    }
    __syncthreads();
    const int h = wave >> 1, ntp = wave & 1;
    bf16x8 Ba[2][2], Bx[2][2];
#pragma unroll
    for (int n2 = 0; n2 < 2; ++n2)
#pragma unroll
        for (int ks = 0; ks < 2; ++ks) { const size_t off = ((size_t)(h * 64 + (ntp * 2 + n2) * 16 + lr)) * 64 + ks * 32 + lq * 8;
            Ba[n2][ks] = *(const bf16x8*)(WAT + off); Bx[n2][ks] = *(const bf16x8*)(WXT + off); }
    float carryH[2] = {0.f, 0.f}, carryA[2] = {1.f, 1.f};
    float ba[2], bx[2], sp[2];
#pragma unroll
    for (int n2 = 0; n2 < 2; ++n2) { const int c = h * 64 + (ntp * 2 + n2) * 16 + lr; ba[n2] = P.in[11][l * 256 + c]; bx[n2] = P.in[13][l * 256 + c]; sp[n2] = log1pf(__expf(-P.in[14][l * 256 + c])); }
#pragma unroll
    for (int mt = 0; mt < 4; ++mt) {
        float gbv[2][4];
#pragma unroll
        for (int n2 = 0; n2 < 2; ++n2)
#pragma unroll
            for (int jj = 0; jj < 4; ++jj) gbv[n2][jj] = bf2f(Z[(row0 + mt * 16 + lq * 4 + jj) * DPROJ + 768 + h * 64 + (ntp * 2 + n2) * 16 + lr]);
        f32x4 accA[2] = {(f32x4){0.f, 0.f, 0.f, 0.f}, (f32x4){0.f, 0.f, 0.f, 0.f}}, accX[2] = {(f32x4){0.f, 0.f, 0.f, 0.f}, (f32x4){0.f, 0.f, 0.f, 0.f}};
#pragma unroll
        for (int ks = 0; ks < 2; ++ks) { const bf16x8 a = ldsfrag(xcB, mt * 16 + lr, 264, h * 64 + ks * 32 + lq * 8);
#pragma unroll
            for (int n2 = 0; n2 < 2; ++n2) { accA[n2] = MFMA16(a, Ba[n2][ks], accA[n2]); accX[n2] = MFMA16(a, Bx[n2][ks], accX[n2]); } }
#pragma unroll
        for (int n2 = 0; n2 < 2; ++n2) {
            const int c = h * 64 + (ntp * 2 + n2) * 16 + lr;
            float aloc[4], hloc[4]; float hrun = 0.f, cum = 1.f;
#pragma unroll
            for (int jj = 0; jj < 4; ++jj) { const int t = mt * 16 + lq * 4 + jj;
                const float r = sigm(accA[n2][jj] + ba[n2]), ig = sigm(accX[n2][jj] + bx[n2]); const float la = -8.f * r * sp[n2]; const float a = __expf(la);
                const float x2 = 2.f * la; const float m2 = (x2 > -0.02f) ? -(x2 * (1.f + x2 * (0.5f + x2 * (0.16666667f + x2 * 0.041666668f)))) : 1.f - a * a;
                const float bt = __builtin_amdgcn_sqrtf(m2) * ig * xcF[t * 256 + c]; hrun = a * hrun + bt; cum *= a; hloc[jj] = hrun; aloc[jj] = cum; }
            float Ae = cum, He = hrun;
            { const float A1 = __shfl_up(Ae, 16), H1 = __shfl_up(He, 16); if (lq >= 1) { He = Ae * H1 + He; Ae = Ae * A1; } }
            { const float A2 = __shfl_up(Ae, 32), H2 = __shfl_up(He, 32); if (lq >= 2) { He = Ae * H2 + He; Ae = Ae * A2; } }
            float Ax = __shfl_up(Ae, 16), Hx = __shfl_up(He, 16); if (lq == 0) { Ax = 1.f; Hx = 0.f; }
            const float Hs = Ax * carryH[n2] + Hx, As = carryA[n2] * Ax;
            const float Ab = __shfl(Ae, 48 + lr), Hb = __shfl(He, 48 + lr);
            carryH[n2] = Ab * carryH[n2] + Hb; carryA[n2] = carryA[n2] * Ab;
#pragma unroll
            for (int jj = 0; jj < 4; ++jj) { const size_t r = row0 + mt * 16 + lq * 4 + jj; const float gg = gelu_t(gbv[n2][jj]);
                HL[r * 256 + c] = (bf16_t)f2bf((aloc[jj] * Hs + hloc[jj]) * gg); CA[r * 256 + c] = (bf16_t)f2bf(As * aloc[jj] * gg); }
        }
    }
    if (lq == 0) {
#pragma unroll
        for (int n2 = 0; n2 < 2; ++n2) { const int c = h * 64 + (ntp * 2 + n2) * 16 + lr; RGA[((size_t)b * 64 + k) * 256 + c] = carryA[n2]; RGH[((size_t)b * 64 + k) * 256 + c] = carryH[n2]; }
    }
    __syncthreads();
}

template <int MODE>
__device__ __forceinline__ void hgrn2_unit(const Params& P, int l, int unit, LAS unsigned char* lds, int tid) {
    const int lane = tid & 63, wave = __builtin_amdgcn_readfirstlane(tid >> 6), lr = lane & 15, lq = lane >> 4;
    const int hp = unit & 1, n = (unit >> 1) & 63, b = unit >> 7; const size_t row0 = (size_t)b * SEQ + n * 64;
    LAS float* SEG = (LAS float*)(lds + 124928);
    LAS bf16_t* K2T = (LAS bf16_t*)lds;
    LAS bf16_t* VT = (LAS bf16_t*)(lds + (MODE == 0 ? 18432 : 52224));
    LAS bf16_t* QS = (LAS bf16_t*)lds;
    LAS bf16_t* KS = (LAS bf16_t*)(lds + 17408);
    LAS bf16_t* Q2 = (LAS bf16_t*)(lds + 34816);
    LAS bf16_t* PP = (LAS bf16_t*)(lds + 70656) + wave * 16 * 72;
    const bf16_t* Z = (const bf16_t*)(P.ws + WS_Z); bf16_t* MIX = (bf16_t*)(P.ws + WS_MIX);
    {
        const int c = tid & 127, sg = tid >> 7, ch = hp * 128 + c;
        float lb;
        { const float* clb = P.in[15] + ch; const float c0 = clb[0], c1 = clb[256], c2 = clb[512], c3 = clb[768];
          const float mx = fmaxf(fmaxf(c0, c1), fmaxf(c2, c3)); const float e0 = __expf(c0 - mx), e1 = __expf(c1 - mx), e2 = __expf(c2 - mx), e3 = __expf(c3 - mx);
          const float num = (l >= 1 ? e1 : 0.f) + (l >= 2 ? e2 : 0.f) + (l >= 3 ? e3 : 0.f); lb = num / (e0 + e1 + e2 + e3); }
        const bf16_t* zr = Z + (row0 + sg * 16) * DPROJ + 1024 + ch;
        float fr[16], iv[16], qv[16];
#pragma unroll
        for (int j = 0; j < 16; ++j) { fr[j] = bf2f(zr[(size_t)j * DPROJ + 256]); iv[j] = bf2f(zr[(size_t)j * DPROJ + 512]); if (MODE == 1) qv[j] = bf2f(zr[(size_t)j * DPROJ]); }
        float pre[16], kf[16]; float run = 0.f;
#pragma unroll
        for (int j = 0; j < 16; ++j) { const float fg = lb + (1.f - lb) * sigm(fr[j]); kf[j] = 1.f - fg; run += __logf(fg); pre[j] = run; }
        SEG[sg * 128 + c] = run;
        __syncthreads();
        const float s0 = SEG[c], s1 = SEG[128 + c], s2 = SEG[256 + c], s3 = SEG[384 + c];
        const float off = (sg >= 1 ? s0 : 0.f) + (sg >= 2 ? s1 : 0.f) + (sg >= 3 ? s2 : 0.f);
        const float bm = s0 + s1, bl = (s0 + s1) + (s2 + s3);
        unsigned pv[8], pk2_[8];
#pragma unroll
        for (int j = 0; j < 16; ++j) {
            const float bb = off + pre[j]; const int t = sg * 16 + j;
            const unsigned vb = f2bf(iv[j]);
            if (j & 1) pv[j >> 1] |= vb << 16; else pv[j >> 1] = vb;
            if (MODE == 0) { const unsigned kb = f2bf(kf[j] * __expf(bl - bb)); if (j & 1) pk2_[j >> 1] |= kb << 16; else pk2_[j >> 1] = kb; }
            else { const float q = silu_(qv[j]);
                QS[t * 136 + c] = (bf16_t)f2bf(q * __expf(bb - bm)); KS[t * 136 + c] = (bf16_t)f2bf(kf[j] * __expf(bm - bb)); Q2[t * 136 + c] = (bf16_t)f2bf(q * __expf(bb)); }
        }
        { LAS v4u* dst = (LAS v4u*)(VT + c * 72 + sg * 16); dst[0] = (v4u){pv[0], pv[1], pv[2], pv[3]}; dst[1] = (v4u){pv[4], pv[5], pv[6], pv[7]}; }
        if (MODE == 0) { LAS v4u* dst = (LAS v4u*)(K2T + c * 72 + sg * 16); dst[0] = (v4u){pk2_[0], pk2_[1], pk2_[2], pk2_[3]}; dst[1] = (v4u){pk2_[4], pk2_[5], pk2_[6], pk2_[7]};
            if (sg == 0) { const int bh = b * 4 + hp * 2 + (c >> 6); ((float*)(P.ws + WS_DEC))[((size_t)bh * 64 + n) * 64 + (c & 63)] = __expf(bl); } }
    }
    __syncthreads();
    const int hl = wave >> 2, w4 = wave & 3, bh = b * 4 + hp * 2 + hl, h = hp * 2 + hl;
    if (MODE == 0) {
        float* ST = (float*)(P.ws + WS_ST) + ((size_t)bh * 64 + n) * 4096;
        f32x4 acc[4];
#pragma unroll
        for (int dt = 0; dt < 4; ++dt) acc[dt] = (f32x4){0.f, 0.f, 0.f, 0.f};
#pragma unroll
        for (int ks = 0; ks < 2; ++ks) { const bf16x8 a = ldsfrag(VT, hl * 64 + w4 * 16 + lr, 72, ks * 32 + lq * 8);
#pragma unroll
            for (int dt = 0; dt < 4; ++dt) acc[dt] = MFMA16(a, ldsfrag(K2T, hl * 64 + dt * 16 + lr, 72, ks * 32 + lq * 8), acc[dt]); }
#pragma unroll
        for (int dt = 0; dt < 4; ++dt)
#pragma unroll
            for (int jj = 0; jj < 4; ++jj) ST[(w4 * 16 + lq * 4 + jj) * 64 + dt * 16 + lr] = acc[dt][jj];
    } else {
        const int mt = w4;
        const bf16_t* STB = (const bf16_t*)(P.ws + WS_STB) + ((size_t)bh * 64 + n) * 4096;
        bf16x8 Sf[4][2];
#pragma unroll
        for (int nt = 0; nt < 4; ++nt)
#pragma unroll
            for (int ks = 0; ks < 2; ++ks) Sf[nt][ks] = *(const bf16x8*)(STB + (nt * 16 + lr) * 64 + ks * 32 + lq * 8);
        float gv[4][4];
#pragma unroll
        for (int nt = 0; nt < 4; ++nt)
#pragma unroll
            for (int jj = 0; jj < 4; ++jj) gv[nt][jj] = bf2f(Z[(row0 + mt * 16 + lq * 4 + jj) * DPROJ + 1792 + h * 64 + nt * 16 + lr]);
        float ng[4];
#pragma unroll
        for (int nt = 0; nt < 4; ++nt) ng[nt] = P.in[16][l * 64 + nt * 16 + lr];
        const bf16x8 qa0 = ldsfrag(QS, mt * 16 + lr, 136, hl * 64 + lq * 8), qa1 = ldsfrag(QS, mt * 16 + lr, 136, hl * 64 + 32 + lq * 8);
#pragma unroll
        for (int st = 0; st < 4; ++st) {
            f32x4 s = (f32x4){0.f, 0.f, 0.f, 0.f};
            if (st <= mt) { s = MFMA16(qa0, ldsfrag(KS, st * 16 + lr, 136, hl * 64 + lq * 8), s); s = MFMA16(qa1, ldsfrag(KS, st * 16 + lr, 136, hl * 64 + 32 + lq * 8), s); }
#pragma unroll
            for (int jj = 0; jj < 4; ++jj) { const bool keep = (st < mt) || (st == mt && lr <= lq * 4 + jj); PP[(lq * 4 + jj) * 72 + st * 16 + lr] = (bf16_t)f2bf(keep ? s[jj] : 0.f); }
        }
        f32x4 acc[4];
#pragma unroll
        for (int nt = 0; nt < 4; ++nt) acc[nt] = (f32x4){0.f, 0.f, 0.f, 0.f};
        const bf16x8 q20 = ldsfrag(Q2, mt * 16 + lr, 136, hl * 64 + lq * 8), q21 = ldsfrag(Q2, mt * 16 + lr, 136, hl * 64 + 32 + lq * 8);
#pragma unroll
        for (int nt = 0; nt < 4; ++nt) { acc[nt] = MFMA16(q20, Sf[nt][0], acc[nt]); acc[nt] = MFMA16(q21, Sf[nt][1], acc[nt]); }
#pragma unroll
        for (int ks = 0; ks < 2; ++ks) if (ks * 2 <= mt) { const bf16x8 pa = ldsfrag(PP, lr, 72, ks * 32 + lq * 8);
#pragma unroll
            for (int nt = 0; nt < 4; ++nt) acc[nt] = MFMA16(pa, ldsfrag(VT, hl * 64 + nt * 16 + lr, 72, ks * 32 + lq * 8), acc[nt]); }
#pragma unroll
        for (int jj = 0; jj < 4; ++jj) {
            float ss = (acc[0][jj] * acc[0][jj] + acc[1][jj] * acc[1][jj]) + (acc[2][jj] * acc[2][jj] + acc[3][jj] * acc[3][jj]);
            ss += __shfl_xor(ss, 1); ss += __shfl_xor(ss, 2); ss += __shfl_xor(ss, 4); ss += __shfl_xor(ss, 8);
            const float rstd = rsqrtf(ss * (1.f / 64.f) + EPS);
#pragma unroll
            for (int nt = 0; nt < 4; ++nt) MIX[(row0 + mt * 16 + lq * 4 + jj) * DM + 512 + h * 64 + nt * 16 + lr] = (bf16_t)f2bf(acc[nt][jj] * rstd * ng[nt] * silu_(gv[nt][jj]));
        }
    }
    __syncthreads();
}

#define RLX_AGENT __ATOMIC_RELAXED, __HIP_MEMORY_SCOPE_AGENT
#define XB_TMO      128
#define XB_XCNT(j)  (256  + 64 * (j))
#define XB_XSUB(j)  (1280 + 64 * (j))
#define XB_XGEN(j)  (2304 + 64 * (j))
#define XB_TOP      3328
#define XB_TOPGEN   3392
#define XCD_BAR_WORDS 3456
#define XB_SPIN_CAP (1u << 18)

__device__ __forceinline__ unsigned xb_ld(unsigned* p)              { return __hip_atomic_load(p, __ATOMIC_RELAXED, __HIP_MEMORY_SCOPE_AGENT); }
__device__ __forceinline__ unsigned xb_add(unsigned* p, unsigned v) { return __hip_atomic_fetch_add(p, v, __ATOMIC_RELAXED, __HIP_MEMORY_SCOPE_AGENT); }
__device__ __forceinline__ unsigned xb_xcc_id() { return (unsigned)__builtin_amdgcn_s_getreg((3 << 11) | 20) & 0xFu; }
#define XB_SPIN(cond, bar) do { unsigned _sp = 0; while (cond) { __builtin_amdgcn_s_sleep(1); \
    if ((++_sp & 255u) == 0u) { if (xb_ld(&(bar)[XB_TMO])) break; if (_sp > XB_SPIN_CAP) { atomicAdd(&(bar)[XB_TMO], 1u); break; } } } } while (0)

struct XcdBarrier {
    unsigned* bar; unsigned x;
    volatile LAS unsigned* st;
};

__device__ __forceinline__ XcdBarrier xcd_barrier_post(unsigned* bar, volatile LAS unsigned* st) {
    XcdBarrier b; b.bar = bar; b.x = xb_xcc_id(); b.st = st;
    if (threadIdx.x == 0) (void)xb_add(&bar[XB_XCNT(b.x)], 1u);
    return b;
}
__device__ __forceinline__ void xcd_barrier_complete(unsigned* bar, unsigned x, unsigned& nloc, unsigned& nx) {
    const unsigned G = gridDim.x * gridDim.y * gridDim.z;
    unsigned sum, cnt, mine, sp = 0u;
    for (;;) {
        sum = 0u; cnt = 0u; mine = 0u;
#pragma unroll
        for (unsigned j = 0; j < 16; ++j) { const unsigned c = xb_ld(&bar[XB_XCNT(j)]); sum += c; cnt += (c > 0u) ? 1u : 0u; mine = (j == x) ? c : mine; }
        if (sum == G) break;
        __builtin_amdgcn_s_sleep(1);
        if ((++sp & 255u) == 0u) { if (xb_ld(&bar[XB_TMO])) break; if (sp > XB_SPIN_CAP) { atomicAdd(&bar[XB_TMO], 1u); break; } }
    }
    nloc = mine > 0u ? mine : 1u; nx = cnt > 0u ? cnt : 1u;
}

__device__ __forceinline__ void xcd_barrier(const XcdBarrier& b) {
    asm volatile("s_waitcnt vmcnt(0)" ::: "memory");
    __syncthreads();
    if (threadIdx.x == 0) {
        unsigned* bar = b.bar;
        __builtin_amdgcn_s_waitcnt(0);
        unsigned nloc = b.st[0], nx = b.st[1];
        if (nloc == 0u) { xcd_barrier_complete(bar, b.x, nloc, nx); b.st[0] = nloc; b.st[1] = nx; }
        const unsigned old = xb_add(&bar[XB_XSUB(b.x)], 1u);
        const unsigned gen = old / nloc;
        if (old + 1u == (gen + 1u) * nloc) {
            __builtin_amdgcn_fence(__ATOMIC_RELEASE, "agent");
            asm volatile("s_waitcnt vmcnt(0)" ::: "memory");
            const unsigned og = xb_add(&bar[XB_TOP], 1u);
            const unsigned tg = og / nx;
            if (og + 1u == (tg + 1u) * nx) xb_add(&bar[XB_TOPGEN], 1u);
            else XB_SPIN(xb_ld(&bar[XB_TOPGEN]) == tg, bar);
            __builtin_amdgcn_fence(__ATOMIC_ACQUIRE, "agent");
            xb_add(&bar[XB_XGEN(b.x)], 1u);
            asm volatile("s_waitcnt vmcnt(0)" ::: "memory");
        } else {
            XB_SPIN(xb_ld(&bar[XB_XGEN(b.x)]) == gen, bar);
            __builtin_amdgcn_fence(__ATOMIC_ACQUIRE, "agent");
            asm volatile("s_waitcnt vmcnt(0)" ::: "memory");
        }
    }
    __syncthreads();
}

__global__ void __launch_bounds__(NT, 2) mega_fwd(Params P) {
    extern __shared__ __attribute__((aligned(16))) unsigned char lds_raw[];
    LAS unsigned char* lds = (LAS unsigned char*)lds_raw;
    cg::grid_group grid = cg::this_grid();
    const int G = gridDim.x, bid = blockIdx.x;
    const int NGW = G * NWAVES, NTHR = G * NT;
    volatile LAS unsigned* MISC = (volatile LAS unsigned*)(lds + LDS_BYTES - 64);
    if (threadIdx.x < 16) MISC[threadIdx.x] = 0u;
    __syncthreads();
    XcdBarrier xbar = xcd_barrier_post((unsigned*)P.ws, MISC);
#define GSYNC() do { xcd_barrier(xbar); for (int r_ = 0; r_ < REP_SYNC; ++r_) xcd_barrier(xbar); } while (0)
#define TIDS int tid = threadIdx.x; asm volatile("" : "+v"(tid)); const int lane = tid & 63, wave = __builtin_amdgcn_readfirstlane(tid >> 6); const int gw = bid * NWAVES + wave, gtid = bid * NT + tid; (void)lane; (void)gw; (void)gtid;
    unsigned char* ws = P.ws;
    bf16_t* WIN = (bf16_t*)(ws + WS_WIN); bf16_t* WOUT = (bf16_t*)(ws + WS_WOUT); bf16_t* WUP = (bf16_t*)(ws + WS_WUP);
    bf16_t* WDN = (bf16_t*)(ws + WS_WDN); bf16_t* WPG = (bf16_t*)(ws + WS_WPG); bf16_t* WPE = (bf16_t*)(ws + WS_WPE);
    bf16_t* XB0 = (bf16_t*)(ws + WS_H); bf16_t* XB1 = (bf16_t*)(ws + WS_XB1); float* SS = (float*)(ws + WS_SS);
    bf16_t* PBF = (bf16_t*)(ws + WS_PBF); bf16_t* ACT = (bf16_t*)(ws + WS_ACT); bf16_t* HF = (bf16_t*)(ws + WS_HF);
    bf16_t* Zb = (bf16_t*)(ws + WS_Z); bf16_t* MIX = (bf16_t*)(ws + WS_MIX); bf16_t* PEb = (bf16_t*)(ws + WS_PE);
    float* X = P.out;

#define GEMM(Aop, Bop, Nn, Kk, MODE, Optr, LDC, SSI, SSO, XBO, XBI) do { pg8::Gemm g{Aop, Bop, MROWS, Nn, Kk, 0}; pg8::Epi<MODE> E{Optr, LDC, XBI, PEb, SSI, SSO, XBO, nullptr, nullptr, nullptr}; pg8::StaticOrder S; S.init(MROWS, Nn, G, bid); \
        pg8::gemm_phase<pg8::Epi<MODE>, pg8::StaticOrder, true, true>(lds, g, S, E); } while (0)
    for (int l_ = 0; l_ < DEPTH; ++l_) {
        {
            int l = l_; asm volatile("" : "+s"(l));
            bf16_t* XBc = XB0; bf16_t* XBn = XB1;     float* SSl = SS + (size_t)3 * l * MROWS * 16;
            for (int re_ = 0; re_ < REP_ELT; ++re_) {   TIDS
                LAS float* scr = (LAS float*)(lds + wave * 16384);
                const float* w_in = P.in[3] + (size_t)l * DM * DPROJ; const float* w_out = P.in[19] + (size_t)l * DM * DM; const float* w_up = P.in[21] + (size_t)l * DM * 2 * DFF;
                const float* w_dn = P.in[24] + (size_t)l * DFF * DM; const float* w_pe = P.in[26] + (size_t)l * PLE * DM; const float* w_pg = P.in[27] + (size_t)l * DM * DM;
                for (int it = gw; it < 6528; it += NGW) {
                    int r = it;
                    if (r < 1152) { transpose_item(w_in, DM, DPROJ, WIN, scr, r, lane, P.in[2] + l * DM); continue; } r -= 1152;
                    if (r < 512) { transpose_item(w_out, DM, DM, WOUT, scr, r, lane, nullptr); continue; } r -= 512;
                    if (r < 2816) { transpose_item(w_up, DM, 2 * DFF, WUP, scr, r, lane, P.in[20] + l * DM, true); continue; } r -= 2816;
                    if (r < 1408) { transpose_item(w_dn, DFF, DM, WDN, scr, r, lane, nullptr); continue; } r -= 1408;
                    if (r < 512) { transpose_item(w_pg, DM, DM, WPG, scr, r, lane, P.in[25] + l * DM); continue; } r -= 512;
                    transpose_item(w_pe, PLE, DM, WPE, scr, r, lane, nullptr);
                }
                const float* pl = P.in[1] + (size_t)l * MROWS * PLE;
                for (int i = gtid; i < MROWS * PLE / 8; i += NTHR) { const f32x4 a = __builtin_nontemporal_load(&((const f32x4*)pl)[2 * i]), b2 = __builtin_nontemporal_load(&((const f32x4*)pl)[2 * i + 1]);
                    v4u w; w.x = pk2(a.x, a.y); w.y = pk2(a.z, a.w); w.z = pk2(b2.x, b2.y); w.w = pk2(b2.z, b2.w); ((v4u*)PBF)[i] = w; }
                { bf16_t* WSM = (bf16_t*)(ws + WS_WSM); bf16_t* WAT = (bf16_t*)(ws + WS_WAT); bf16_t* WXT = (bf16_t*)(ws + WS_WXT); bf16_t* WDT = (bf16_t*)(ws + WS_WDT);
                  const float* aws = P.in[6] + (size_t)l * 65536; const float* bwa = P.in[10] + (size_t)l * 16384; const float* bwx = P.in[12] + (size_t)l * 16384; const float* dw = P.in[17] + (size_t)l * 16384;
                  for (int i = gtid; i < 65536 + 3 * 16384; i += NTHR) {
                      if (i < 65536) { const int t = (i >> 7) & 127, sx = i & 127; WSM[i] = (bf16_t)f2bf(sx <= t ? aws[i] : 0.f); }
                      else { const int r = i - 65536, m = r >> 14, q = r & 16383, hh = q >> 12, e = (q >> 6) & 63, d = q & 63; const int src = hh * 4096 + d * 64 + e;
                          if (m == 0) WAT[q] = (bf16_t)f2bf(bwa[src]); else if (m == 1) WXT[q] = (bf16_t)f2bf(bwx[src]); else WDT[q] = (bf16_t)f2bf(dw[src]); } } }
                if (l == 0) {
                    for (int m = gw; m < MROWS; m += NGW) {
                        const f32x4* xr = (const f32x4*)(P.in[0] + (size_t)m * DM) + lane; f32x4 v[4]; float sq = 0.f;
#pragma unroll
                        for (int j = 0; j < 4; ++j) { v[j] = xr[64 * j]; sq += (v[j].x * v[j].x + v[j].y * v[j].y) + (v[j].z * v[j].z + v[j].w * v[j].w); }
                        sq = wave_sum(sq); if (lane < 16) SS[(size_t)m * 16 + lane] = (lane == 0) ? sq : 0.f;
                        v2u* o8 = (v2u*)(XB1 + (size_t)m * DM) + lane;
#pragma unroll
                        for (int j = 0; j < 4; ++j) { v2u w; w.x = pk2(v[j].x, v[j].y); w.y = pk2(v[j].z, v[j].w); o8[64 * j] = w; }
                    }
                }
            }
            if (P.out == nullptr) grid.sync();
            GSYNC();
            GEMM(XBn, WIN, DPROJ, DM, 0, Zb, DPROJ, SSl, nullptr, nullptr, nullptr);
            {
                pg8::Gemm g{PBF, WPE, MROWS, DM, PLE, 0}; pg8::Epi<0> E{PEb, DM, nullptr, PEb, nullptr, nullptr, nullptr, nullptr, nullptr, nullptr};
                pg8::StaticOrder S; S.init(MROWS, DM, G > 64 ? G - 64 : G, G > 64 ? (bid >= 64 ? bid - 64 : (1 << 20)) : bid);
                pg8::gemm_phase<pg8::Epi<0>, pg8::StaticOrder, true, true>(lds, g, S, E); }
            GSYNC();
            for (int rm_ = 0; rm_ < REP_MIX; ++rm_) {
            {   TIDS
                for (int it = bid; it < 256 + 256 + 256 + 512; it += G) {
                    int t2 = tid; asm volatile("" : "+v"(t2));
                    if (it < 256) gmlp2_unit(P, l, it, lds, t2);
                    else if (it < 512) pool2_unit(P, l, it - 256, lds, t2);
                    else if (it < 768) rglru2_unit(P, l, it - 512, lds, t2);
                    else hgrn2_unit<0>(P, l, it - 768, lds, t2);
                }
            }
            GSYNC();
            {   TIDS
                if (gtid < 65536) { const int bh = gtid >> 12, e = gtid & 4095, d = e & 63; float s = 0.f;
                    const float* stp = (const float*)(ws + WS_ST) + (size_t)bh * 64 * 4096 + e; bf16_t* sbp = (bf16_t*)(ws + WS_STB) + (size_t)bh * 64 * 4096 + e; const float* dc = (const float*)(ws + WS_DEC) + bh * 64 * 64 + d;
#pragma unroll 1
                    for (int c0 = 0; c0 < 64; c0 += 16) { float kk[16], dd[16];
#pragma unroll
                        for (int j = 0; j < 16; ++j) { kk[j] = stp[(size_t)(c0 + j) * 4096]; dd[j] = dc[(c0 + j) * 64]; }
                        __builtin_amdgcn_sched_barrier(0);
#pragma unroll
                        for (int j = 0; j < 16; ++j) { sbp[(size_t)(c0 + j) * 4096] = (bf16_t)f2bf(s); s = dd[j] * s + kk[j]; } }
                } else if (gtid < 65536 + 1024) { const int q = gtid - 65536, b = q >> 8, c = q & 255; float carry = 0.f;
                    const float* ra = (const float*)(ws + WS_RGA) + (size_t)b * 64 * 256 + c; const float* rh = (const float*)(ws + WS_RGH) + (size_t)b * 64 * 256 + c; float* cr = (float*)(ws + WS_CARRY) + (size_t)b * 64 * 256 + c;
#pragma unroll 1
                    for (int k0 = 0; k0 < 64; k0 += 16) { float aa[16], hh[16];
#pragma unroll
                        for (int j = 0; j < 16; ++j) { aa[j] = ra[(k0 + j) * 256]; hh[j] = rh[(k0 + j) * 256]; }
                        __builtin_amdgcn_sched_barrier(0);
#pragma unroll
                        for (int j = 0; j < 16; ++j) { cr[(k0 + j) * 256] = carry; carry = aa[j] * carry + hh[j]; } }
                }
            }
            GSYNC();
            {   TIDS
                const v4u* HL = (const v4u*)(ws + WS_HL); const v4u* CA = (const v4u*)(ws + WS_CA); const float* cr = (const float*)(ws + WS_CARRY);
                for (int i0 = gtid; i0 < MROWS * 32; i0 += 2 * NTHR) {
                    const int i1 = i0 + NTHR; const bool v1 = i1 < MROWS * 32; const int ix = v1 ? i1 : i0;
                    const int rowa = i0 >> 5, c0a = (i0 & 31) * 8, rowb = ix >> 5, c0b = (ix & 31) * 8;
                    const v4u hla = HL[i0], caa = CA[i0], hlb = HL[ix], cab = CA[ix];
                    const f32x4* cpa = (const f32x4*)(cr + ((size_t)(rowa >> 12) * 64 + ((rowa & 4095) >> 6)) * 256 + c0a); const f32x4* cpb = (const f32x4*)(cr + ((size_t)(rowb >> 12) * 64 + ((rowb & 4095) >> 6)) * 256 + c0b);
                    const f32x4 a0 = cpa[0], a1 = cpa[1], b0 = cpb[0], b1 = cpb[1];
                    __builtin_amdgcn_sched_barrier(0);
                    { v4u w; w.x = pk2(bflo(hla.x) + bflo(caa.x) * a0.x, bfhi(hla.x) + bfhi(caa.x) * a0.y); w.y = pk2(bflo(hla.y) + bflo(caa.y) * a0.z, bfhi(hla.y) + bfhi(caa.y) * a0.w);
                      w.z = pk2(bflo(hla.z) + bflo(caa.z) * a1.x, bfhi(hla.z) + bfhi(caa.z) * a1.y); w.w = pk2(bflo(hla.w) + bflo(caa.w) * a1.z, bfhi(hla.w) + bfhi(caa.w) * a1.w);
                      *(v4u*)(MIX + (size_t)rowa * DM + 256 + c0a) = w; }
                    if (v1) { v4u w; w.x = pk2(bflo(hlb.x) + bflo(cab.x) * b0.x, bfhi(hlb.x) + bfhi(cab.x) * b0.y); w.y = pk2(bflo(hlb.y) + bflo(cab.y) * b0.z, bfhi(hlb.y) + bfhi(cab.y) * b0.w);
                      w.z = pk2(bflo(hlb.z) + bflo(cab.z) * b1.x, bfhi(hlb.z) + bfhi(cab.z) * b1.y); w.w = pk2(bflo(hlb.w) + bflo(cab.w) * b1.z, bfhi(hlb.w) + bfhi(cab.w) * b1.w);
                      *(v4u*)(MIX + (size_t)rowb * DM + 256 + c0b) = w; }
                }
                for (int it = bid; it < 512; it += G) { int t2 = tid; asm volatile("" : "+v"(t2)); hgrn2_unit<1>(P, l, it, lds, t2); }
            }
            GSYNC();
            }
            GEMM(MIX, WOUT, DM, DM, 1, nullptr, 0, nullptr, SSl + MROWS * 16, XBc, XBn);
            GSYNC();
            for (int r_ = 0; r_ < REP_UP; ++r_) {
                pg8::Gemm g{XBc, WUP, 68 * 256, 2 * DFF, DM, 1}; pg8::Epi<3> E{ACT, DFF, nullptr, PEb, SSl + MROWS * 16, nullptr, nullptr, P.in[22] + (size_t)l * 3 * 2 * DFF, P.in[23] + (size_t)l * 2 * DFF, (PG8_LAS float*)(lds + 131072)};
                pg8::StaticOrder S; S.init(68 * 256, 2 * DFF, G, bid); pg8::gemm_phase<pg8::Epi<3>, pg8::StaticOrder, true, true>(lds, g, S, E); }
            GSYNC();
            GEMM(ACT, WDN, DM, DFF, 1, nullptr, 0, nullptr, SSl + 2 * MROWS * 16, XBc, XBc);
            GSYNC();
            GEMM(XBc, WPG, DM, DM, 2, nullptr, 0, SSl + 2 * MROWS * 16, SSl + 3 * MROWS * 16, XBn, XBc);
            GSYNC();
        }
    }
    TIDS
    for (int m = gw; m < MROWS; m += NGW) {
        f32x4* xr = (f32x4*)(X + (size_t)m * DM) + lane; const v2u* xb = (const v2u*)(XB1 + (size_t)m * DM) + lane;
        float t = SS[((size_t)12 * MROWS + m) * 16 + (lane & 15)]; t += __shfl_xor(t, 1); t += __shfl_xor(t, 2); t += __shfl_xor(t, 4); t += __shfl_xor(t, 8); const float rs = rsqrtf(t * (1.f / DM) + EPS);
#pragma unroll
        for (int j = 0; j < 4; ++j) { const f32x4 g4 = ((const f32x4*)P.in[28])[lane + 64 * j]; const v2u w = xb[64 * j]; const f32x4 xv = {bflo(w.x), bfhi(w.x), bflo(w.y), bfhi(w.y)}; xr[64 * j] = xv * rs * g4; }
    }
}

extern "C" void kernel_launch(void* const* d_in, const int* in_sizes, int n_in, void* d_out, int out_size, void* d_ws, size_t ws_size, hipStream_t stream) {
    static int grid = 0;
    if (grid == 0) {
        if (n_in != 29 || out_size != MROWS * DM || ws_size < WS_END) { fprintf(stderr, "kernel_launch: unexpected shapes: n_in %d out %d ws %zu (need %zu)\n", n_in, out_size, ws_size, (size_t)WS_END); grid = -1; return; }
        int dev = 0, cus = 0, per_cu = 0;
        hipGetDevice(&dev); hipDeviceGetAttribute(&cus, hipDeviceAttributeMultiprocessorCount, dev);
        if (hipFuncSetAttribute((const void*)mega_fwd, hipFuncAttributeMaxDynamicSharedMemorySize, LDS_BYTES) != hipSuccess) { fprintf(stderr, "kernel_launch: hipFuncSetAttribute failed\n"); grid = -1; return; }
        if (hipOccupancyMaxActiveBlocksPerMultiprocessor(&per_cu, (const void*)mega_fwd, NT, LDS_BYTES) != hipSuccess || per_cu < 1) { fprintf(stderr, "kernel_launch: occupancy query failed (%d)\n", per_cu); (void)hipGetLastError(); per_cu = 1; }
        grid = cus * 1;
    }
    if (grid < 0) return;
    if (hipMemsetAsync(d_ws, 0, 65536, stream) != hipSuccess) { fprintf(stderr, "kernel_launch: memset failed\n"); return; }
    Params p{};
    for (int i = 0; i < 29; ++i) p.in[i] = (const float*)d_in[i];
    p.out = (float*)d_out; p.ws = (unsigned char*)d_ws;
    void* args[] = {&p};
    hipError_t e = hipLaunchCooperativeKernel((const void*)mega_fwd, dim3(grid), dim3(NT), args, LDS_BYTES, stream);
    if (e != hipSuccess) fprintf(stderr, "cooperative launch failed: %s (grid %d)\n", hipGetErrorString(e), grid);
}
```

```cpp
#include <hip/hip_runtime.h>
#include <hip/hip_cooperative_groups.h>
#include <cstdio>
#include <cstdint>
namespace cg = cooperative_groups;
#ifndef REP_SYNC
#define REP_SYNC 0
#endif
#ifndef REP_UP
#define REP_UP 1
#endif
#ifndef REP_MIX
#define REP_MIX 1
#endif
#ifndef REP_ELT
#define REP_ELT 1
#endif
namespace pg8 {
#define PG8_LAS __attribute__((address_space(3)))
typedef unsigned short bf16_t;
typedef short bf16x8 __attribute__((ext_vector_type(8)));
typedef float f32x4 __attribute__((ext_vector_type(4)));
typedef unsigned u32x4 __attribute__((ext_vector_type(4)));
constexpr int BM = 256, BK = 64, HALF = 128, HTB = HALF * BK * 2  , STAGE_BYTES = 8 * HTB, NXCD = 8, WGM = 8;
__host__ __device__ __forceinline__ int lds_byte(int r, int c) { const int st = (r >> 4) * 2 + (c >> 5), rr = r & 15, cc = c & 31, ob = rr * 64 + cc * 2; return st * 1024 + (ob ^ (((ob >> 9) & 1) << 5)); }
__host__ __device__ __forceinline__ void stage_rc(int b, int& R, int& C) { const int st = b / 1024, sb = b % 1024, swz = sb ^ (((sb >> 9) & 1) << 5); R = (st >> 1) * 16 + swz / 64; C = (st & 1) * 32 + (swz % 64) / 2; }
__host__ __device__ __forceinline__ int perm32(int rho) { const int n = rho >> 4, i = rho & 15; return 8 * (i >> 2) + 4 * n + (i & 3); }
struct Unit { int pm, pn; };
struct Gemm { const bf16_t* A; const bf16_t* Bt; int M, N, K; int conv; };
__host__ __device__ __forceinline__ long conv_rowbase(int pm) { return (long)(pm / 17) * 4096 + 254 * (pm % 17) - 2; }
struct StaticOrder {
    int nM, nN, nwg, G, c;
    __host__ __device__ void init(int M, int N, int G_, int c_) { nM = M / BM; nN = N / BM; nwg = nM * nN; G = G_; c = c_; }
    __host__ __device__ bool next(int i, Unit& u) const {
        const long L = (long)i * G + c; if (L >= nwg) return false;
        int wgid = (int)L; { const int q = nwg / NXCD, r = nwg % NXCD, xcd = wgid % NXCD, off = wgid / NXCD; wgid = (xcd < r ? xcd * (q + 1) : r * (q + 1) + (xcd - r) * q) + off; }
        const int nig = WGM * nN, gid = wgid / nig, fm = gid * WGM, gsz = (nM - fm) < WGM ? (nM - fm) : WGM;
        u.pm = fm + ((wgid % nig) % gsz); u.pn = (wgid % nig) / gsz; return true;
    }
    __device__ __forceinline__ void a_ready(const Unit&) const {}
    __device__ __forceinline__ void done(const Unit&) const {}
};
__device__ __forceinline__ unsigned cvt_pk_bf16(float lo, float hi) { unsigned r; asm volatile("v_cvt_pk_bf16_f32 %0, %1, %2" : "=v"(r) : "v"(lo), "v"(hi)); return r; }
__device__ __forceinline__ float bf_lo(unsigned w) { return __uint_as_float(w << 16); }
__device__ __forceinline__ float bf_hi(unsigned w) { return __uint_as_float(w & 0xffff0000u); }
template <int mode> struct Epi {
    static constexpr bool PERM = true, AFTER_DRAIN = false;
    bf16_t* O; int ldc; const bf16_t* XBi; const bf16_t* PE; const float* SSin; float* SSout; bf16_t* XBo;
    const float* cw; const float* cb; PG8_LAS float* exch;
    __device__ __forceinline__ void operator()(f32x4 (&acc)[2][2][4][2], const Unit& u, int wr, int wc, int fr, int fq) const {
        if constexpr (mode == 3) { conv_epi(acc, u, wr, wc, fr, fq); return; }
        const int row0 = u.pm * BM + wr * 64 + fr, col0 = u.pn * BM + wc * 32 + 8 * fq;
        float rsv[2][4];
        if (mode != 1 && SSin) { f32x4 p4[2][4];
#pragma unroll
            for (int ai = 0; ai < 2; ++ai)
#pragma unroll
                for (int m = 0; m < 4; ++m) p4[ai][m] = *(const f32x4*)(SSin + (size_t)(row0 + ai * HALF + m * 16) * 16 + 4 * fq);
            __builtin_amdgcn_sched_barrier(0);
#pragma unroll
            for (int ai = 0; ai < 2; ++ai)
#pragma unroll
                for (int m = 0; m < 4; ++m) { float t = (p4[ai][m][0] + p4[ai][m][1]) + (p4[ai][m][2] + p4[ai][m][3]); t += __shfl_xor(t, 16); t += __shfl_xor(t, 32); rsv[ai][m] = rsqrtf(t * (1.f / 1024.f) + 1e-6f); }
        } else {
#pragma unroll
            for (int ai = 0; ai < 2; ++ai)
#pragma unroll
                for (int m = 0; m < 4; ++m) rsv[ai][m] = 1.f;
        }
        if (mode == 0) {
#pragma unroll
            for (int ai = 0; ai < 2; ++ai)
#pragma unroll
                for (int m = 0; m < 4; ++m) { const float rs = rsv[ai][m]; bf16_t* rowp = O + (size_t)(row0 + ai * HALF + m * 16) * ldc + col0;
#pragma unroll
                    for (int bj = 0; bj < 2; ++bj) { const f32x4 v0 = acc[ai][bj][m][0] * rs, v1 = acc[ai][bj][m][1] * rs;
                        u32x4 w; w.x = cvt_pk_bf16(v0[0], v0[1]); w.y = cvt_pk_bf16(v0[2], v0[3]); w.z = cvt_pk_bf16(v1[0], v1[1]); w.w = cvt_pk_bf16(v1[2], v1[3]);
                        *(u32x4*)(rowp + bj * HALF) = w; } }
        } else {
#pragma unroll
            for (int ab = 0; ab < 4; ++ab) { const int ai = ab >> 1, mb = (ab & 1) * 2;
                u32x4 xi[2][2], pe[2][2];
#pragma unroll
                for (int mm = 0; mm < 2; ++mm)
#pragma unroll
                    for (int bj = 0; bj < 2; ++bj) { const size_t off = (size_t)(row0 + ai * HALF + (mb + mm) * 16) * 1024 + col0 + bj * HALF;
                        xi[mm][bj] = *(const u32x4*)(XBi + off); if (mode == 2) pe[mm][bj] = *(const u32x4*)(PE + off); }
                __builtin_amdgcn_sched_barrier(0);
#pragma unroll
                for (int mm = 0; mm < 2; ++mm) { const int m = mb + mm; const int row = row0 + ai * HALF + m * 16; const size_t off = (size_t)row * 1024 + col0; const float rs = rsv[ai][m]; float ss = 0.f;
#pragma unroll
                    for (int bj = 0; bj < 2; ++bj) { const u32x4 x4 = xi[mm][bj];
                        const f32x4 a = {bf_lo(x4.x), bf_hi(x4.x), bf_lo(x4.y), bf_hi(x4.y)}, b = {bf_lo(x4.z), bf_hi(x4.z), bf_lo(x4.w), bf_hi(x4.w)}; f32x4 x0, x1;
                        if (mode == 1) { x0 = a + acc[ai][bj][m][0]; x1 = b + acc[ai][bj][m][1]; }
                        else { const u32x4 p4 = pe[mm][bj]; const f32x4 v0 = acc[ai][bj][m][0] * rs, v1 = acc[ai][bj][m][1] * rs; f32x4 s0, s1;
#pragma unroll
                            for (int j = 0; j < 4; ++j) { s0[j] = __builtin_amdgcn_rcpf(1.f + __builtin_amdgcn_exp2f(-1.4426950408889634f * v0[j])); s1[j] = __builtin_amdgcn_rcpf(1.f + __builtin_amdgcn_exp2f(-1.4426950408889634f * v1[j])); }
                            const f32x4 e0 = {bf_lo(p4.x), bf_hi(p4.x), bf_lo(p4.y), bf_hi(p4.y)}, e1 = {bf_lo(p4.z), bf_hi(p4.z), bf_lo(p4.w), bf_hi(p4.w)};
                            x0 = a + e0 * s0; x1 = b + e1 * s1; }
                        u32x4 w; w.x = cvt_pk_bf16(x0[0], x0[1]); w.y = cvt_pk_bf16(x0[2], x0[3]); w.z = cvt_pk_bf16(x1[0], x1[1]); w.w = cvt_pk_bf16(x1[2], x1[3]);
                        *(u32x4*)(XBo + off + bj * HALF) = w;
                        ss += (x0[0] * x0[0] + x0[1] * x0[1]) + (x0[2] * x0[2] + x0[3] * x0[3]) + (x1[0] * x1[0] + x1[1] * x1[1]) + (x1[2] * x1[2] + x1[3] * x1[3]); }
                    ss += __shfl_xor(ss, 16); ss += __shfl_xor(ss, 32);
                    if (fq == 0) SSout[(size_t)row * 16 + u.pn * 4 + wc] = ss;
                }
            }
        }
    }

    static __device__ __forceinline__ float dpp_shr1(float oldv, float src) { return __int_as_float(__builtin_amdgcn_update_dpp(__float_as_int(oldv), __float_as_int(src), 0x111, 0xf, 0xf, false)); }
    static __device__ __forceinline__ float dpp_shr2(float oldv, float src) { return __int_as_float(__builtin_amdgcn_update_dpp(__float_as_int(oldv), __float_as_int(src), 0x112, 0xf, 0xf, false)); }
    static __device__ __forceinline__ float dpp_ror1(float src) { return __int_as_float(__builtin_amdgcn_update_dpp(0, __float_as_int(src), 0x121, 0xf, 0xf, false)); }
    static __device__ __forceinline__ float dpp_ror2(float src) { return __int_as_float(__builtin_amdgcn_update_dpp(0, __float_as_int(src), 0x122, 0xf, 0xf, false)); }
    __device__ __forceinline__ void conv_epi(f32x4 (&acc)[2][2][4][2], const Unit& u, int wr, int wc, int fr, int fq) const {
        const int bq = u.pm / 17, jt = u.pm % 17, tp0 = 254 * jt - 2 + wr * 64 + 4 * fr;
        const int wave = wr * 4 + wc;
        PG8_LAS float* wl = exch + 2048;
        { typedef float f32x2e __attribute__((ext_vector_type(2))); const int idx = (wave * 64 + fq * 16 + fr) * 2, kind = idx >> 7, ch = idx & 127;
          const float* src = ((kind & 3) < 3 ? cw + (kind & 3) * 5632 : cb) + (kind >> 2) * 2816 + u.pn * 128 + ch;
          *(PG8_LAS f32x2e*)(wl + idx) = *(const f32x2e*)src; }
        f32x4 pq[2][4];
#pragma unroll
        for (int ai = 0; ai < 2; ++ai)
#pragma unroll
            for (int m = 0; m < 4; ++m) pq[ai][m] = *(const f32x4*)(SSin + ((long)bq * 4096 + tp0 + ai * HALF + m) * 16 + 4 * fq);
        __builtin_amdgcn_sched_barrier(0);
#pragma unroll
        for (int ai = 0; ai < 2; ++ai)
#pragma unroll
            for (int m = 0; m < 4; ++m) { const int tp = tp0 + ai * HALF + m;
                const f32x4 p4 = pq[ai][m]; float t = (p4[0] + p4[1]) + (p4[2] + p4[3]); t += __shfl_xor(t, 16); t += __shfl_xor(t, 32);
                const float rs = rsqrtf(t * (1.f / 1024.f) + 1e-6f);
                if (ai == 0 && m < 2 && jt == 0 && wr == 0) {
#pragma unroll
                    for (int bj = 0; bj < 2; ++bj)
#pragma unroll
                        for (int n = 0; n < 2; ++n)
#pragma unroll
                            for (int j = 0; j < 4; ++j) acc[ai][bj][m][n][j] = (tp >= 0) ? acc[ai][bj][m][n][j] * rs : 0.f;
                } else {
#pragma unroll
                    for (int bj = 0; bj < 2; ++bj) { acc[ai][bj][m][0] *= rs; acc[ai][bj][m][1] *= rs; }
                } }
        if (fr == 15) {
#pragma unroll
            for (int ai = 0; ai < 2; ++ai)
#pragma unroll
                for (int bj = 0; bj < 2; ++bj)
#pragma unroll
                    for (int n = 0; n < 2; ++n)
#pragma unroll
                        for (int j = 0; j < 4; ++j) { typedef float f32x2e __attribute__((ext_vector_type(2)));
                            *(PG8_LAS f32x2e*)(exch + ((wave * 2 + ai) * 16 + bj * 8 + n * 4 + j) * 8 + fq * 2) = (f32x2e){acc[ai][bj][2][n][j], acc[ai][bj][3][n][j]}; }
        }
        asm volatile("s_waitcnt lgkmcnt(0)" ::: "memory"); __builtin_amdgcn_s_barrier(); asm volatile("" ::: "memory");
        const int cch = u.pn * 128 + wc * 32 + 8 * fq;
#pragma unroll
        for (int ai = 0; ai < 2; ++ai) {
            const bool has_prev = (wr == 1) || (ai == 1);
            const int pw = (wr == 1 ? 0 : 4) + wc, pai = (wr == 1) ? ai : 0;
            unsigned ow[4][4];
#pragma unroll
            for (int n = 0; n < 2; ++n)
#pragma unroll
                for (int jp = 0; jp < 2; ++jp) {
                    float o[4][2];
#pragma unroll
                    for (int jj = 0; jj < 2; ++jj) {
                        const int j = 2 * jp + jj; const PG8_LAS float* wc_ = wl + wc * 32 + 8 * fq + 4 * n + j;
                        const float wg0 = wc_[0], wg1 = wc_[128], wg2 = wc_[256], bg = wc_[384], wv0 = wc_[512], wv1 = wc_[640], wv2 = wc_[768], bv = wc_[896];
                        float pg2 = 0.f, pg3 = 0.f, pv2 = 0.f, pv3 = 0.f;
                        if (has_prev) { typedef float f32x2e __attribute__((ext_vector_type(2)));
                            const f32x2e a = *(const PG8_LAS f32x2e*)(exch + ((pw * 2 + pai) * 16 + n * 4 + j) * 8 + fq * 2), b = *(const PG8_LAS f32x2e*)(exch + ((pw * 2 + pai) * 16 + 8 + n * 4 + j) * 8 + fq * 2);
                            pg2 = a.x; pg3 = a.y; pv2 = b.x; pv3 = b.y; }
                        const float G0 = acc[ai][0][0][n][j], G1 = acc[ai][0][1][n][j], G2 = acc[ai][0][2][n][j], G3 = acc[ai][0][3][n][j];
                        const float V0 = acc[ai][1][0][n][j], V1 = acc[ai][1][1][n][j], V2 = acc[ai][1][2][n][j], V3 = acc[ai][1][3][n][j];
                        const float Gm1 = dpp_shr1(pg3, G3), Gm2 = dpp_shr1(pg2, G2), Vm1 = dpp_shr1(pv3, V3), Vm2 = dpp_shr1(pv2, V2);
                        const float cg[4] = {bg + wg0 * Gm2 + wg1 * Gm1 + wg2 * G0, bg + wg0 * Gm1 + wg1 * G0 + wg2 * G1, bg + wg0 * G0 + wg1 * G1 + wg2 * G2, bg + wg0 * G1 + wg1 * G2 + wg2 * G3};
                        const float cv[4] = {bv + wv0 * Vm2 + wv1 * Vm1 + wv2 * V0, bv + wv0 * Vm1 + wv1 * V0 + wv2 * V1, bv + wv0 * V0 + wv1 * V1 + wv2 * V2, bv + wv0 * V1 + wv1 * V2 + wv2 * V3};
#pragma unroll
                        for (int m = 0; m < 4; ++m) { o[m][jj] = cg[m] * __builtin_amdgcn_rcpf(1.f + __builtin_amdgcn_exp2f(cg[m] * (-2.3022081980f + -0.1029432398f * (cg[m] * cg[m])))) * cv[m]; }
                    }
#pragma unroll
                    for (int m = 0; m < 4; ++m) ow[m][2 * n + jp] = cvt_pk_bf16(o[m][0], o[m][1]);
                    asm volatile("" ::: "memory");
                }
#pragma unroll
            for (int m = 0; m < 4; ++m) { const int r = ai * HALF + wr * 64 + 4 * fr + m, tp = tp0 + ai * HALF + m;
                if (r >= 2 && tp < 4096) { u32x4 w; w.x = ow[m][0]; w.y = ow[m][1]; w.z = ow[m][2]; w.w = ow[m][3]; *(u32x4*)(O + ((size_t)bq * 4096 + tp) * 2816 + cch) = w; } }
        }
    }

};
template <class Epi, class Sched, bool ALIGN_EPI = false, bool SP2 = false>
__device__ __forceinline__ void gemm_phase(PG8_LAS unsigned char* lds, const Gemm g, const Sched& S, const Epi& E) {
    int tid_ = threadIdx.x; asm volatile("" : "+v"(tid_)); const int tid = tid_, wid = __builtin_amdgcn_readfirstlane(tid >> 6), lane = tid & 63, wr = wid >> 2, wc = wid & 3, fr = lane & 15, fq = lane >> 4;
    const int K = g.K, nt = K / BK;
    unsigned voffA[2], voffB[2];
#pragma unroll
    for (int i = 0; i < 2; ++i) { int R, C; stage_rc(tid * 16 + i * 8192, R, C); const int Rb = Epi::PERM ? ((R & ~31) + perm32(R & 31)) : R;
        const int Ra = g.conv ? ((R & ~63) + 4 * (R & 15) + ((R >> 4) & 3)) : R;
        voffA[i] = (unsigned)(Ra * K + C) * 2u; voffB[i] = (unsigned)(Rb * K + C) * 2u; }
    const size_t kstep = (size_t)(BK * 2);
    const size_t hstep = (size_t)HALF * K * 2;
    const size_t tstep = 2 * hstep;
    const unsigned ldsw = (unsigned)wid * 1024u;
    const int aoff = lds_byte(wr * 64 + fr, fq * 8), boff = lds_byte(wc * 32 + fr, fq * 8);
#define PG8_SA(b, h) (((b) * 2 + (h)) * HTB)
#define PG8_SB(b, h) ((4 + (b) * 2 + (h)) * HTB)
#define PG8_STAGE(bufoff, gbase, voff) do { _Pragma("unroll") for (int _i = 0; _i < 2; ++_i) \
        __builtin_amdgcn_global_load_lds((const unsigned*)((const char*)(gbase) + (voff)[_i]), (PG8_LAS unsigned*)(lds + (bufoff) + ldsw + _i * 8192), 16, 0, 0); } while (0)
#define PG8_LDA(dst, b, h) do { _Pragma("unroll") for (int m = 0; m < 4; ++m) _Pragma("unroll") for (int k = 0; k < 2; ++k) dst[m][k] = *(const PG8_LAS bf16x8*)(lds + PG8_SA(b, h) + aoff + m * 2048 + k * 1024); } while (0)
#define PG8_LDB(dst, b, h) do { _Pragma("unroll") for (int n = 0; n < 2; ++n) _Pragma("unroll") for (int k = 0; k < 2; ++k) dst[n][k] = *(const PG8_LAS bf16x8*)(lds + PG8_SB(b, h) + boff + n * 2048 + k * 1024); } while (0)
#define PG8_MMA(ai, bj, At, Bt) do { __builtin_amdgcn_s_setprio(1); _Pragma("unroll") for (int m = 0; m < 4; ++m) _Pragma("unroll") for (int n = 0; n < 2; ++n) _Pragma("unroll") for (int k = 0; k < 2; ++k) \
        acc[ai][bj][m][n] = __builtin_amdgcn_mfma_f32_16x16x32_bf16(Bt[n][k], At[m][k], acc[ai][bj][m][n], 0, 0, 0); __builtin_amdgcn_s_setprio(0); } while (0)
#define PG8_WAIT_V(n) asm volatile("s_waitcnt vmcnt(" #n ")" ::: "memory")
#define PG8_WAIT_L(n) asm volatile("s_waitcnt lgkmcnt(" #n ")" ::: "memory")
#define PG8_BAR __builtin_amdgcn_s_barrier()
#define PG8_SCHED __builtin_amdgcn_sched_barrier(0)
    Unit cur, nxt; int ui = 0;
    if (!S.next(0, cur)) return;
    f32x4 acc[2][2][4][2];
#pragma unroll
    for (int a = 0; a < 2; ++a)
#pragma unroll
        for (int b = 0; b < 2; ++b)
#pragma unroll
            for (int m = 0; m < 4; ++m)
#pragma unroll
                for (int n = 0; n < 2; ++n) acc[a][b][m][n] = (f32x4){0.f, 0.f, 0.f, 0.f};
    bf16x8 At[4][2], B0[2][2], B1[2][2];
    const char* cA = (const char*)g.A + (g.conv ? (size_t)(conv_rowbase(cur.pm) * (long)(K * 2)) : (size_t)cur.pm * tstep); const char* cB = (const char*)g.Bt + (size_t)cur.pn * tstep;
    S.a_ready(cur);
    if constexpr (SP2) {
        PG8_STAGE(PG8_SB(0, 0), cB, voffB); PG8_STAGE(PG8_SB(0, 1), cB + hstep, voffB); PG8_STAGE(PG8_SA(0, 0), cA, voffA); PG8_STAGE(PG8_SA(0, 1), cA + hstep, voffA);
        if (wr == 1) PG8_BAR;
        PG8_WAIT_V(2); PG8_BAR;
        PG8_STAGE(PG8_SB(1, 0), cB + kstep, voffB); PG8_STAGE(PG8_SA(1, 0), cA + kstep, voffA); PG8_STAGE(PG8_SB(1, 1), cB + hstep + kstep, voffB);
        PG8_WAIT_V(6); PG8_BAR;
    } else {
        PG8_STAGE(PG8_SB(0, 0), cB, voffB); PG8_STAGE(PG8_SA(0, 0), cA, voffA); PG8_STAGE(PG8_SB(0, 1), cB + hstep, voffB); PG8_STAGE(PG8_SA(0, 1), cA + hstep, voffA);
        if (wr == 1) PG8_BAR;
        PG8_WAIT_V(4); PG8_BAR;
        PG8_STAGE(PG8_SB(1, 0), cB + kstep, voffB); PG8_STAGE(PG8_SA(1, 0), cA + kstep, voffA); PG8_STAGE(PG8_SB(1, 1), cB + hstep + kstep, voffB);
        PG8_WAIT_V(6); PG8_BAR;
    }
    for (;;) {
        const bool has_next = S.next(ui + 1, nxt);
        const char* nA = has_next ? (const char*)g.A + (g.conv ? (size_t)(conv_rowbase(nxt.pm) * (long)(K * 2)) : (size_t)nxt.pm * tstep) : cA; const char* nB = has_next ? (const char*)g.Bt + (size_t)nxt.pn * tstep : cB;
        for (int t = 0; t < nt; t += 2) {
            const bool last = (t == nt - 2);
            const char* a1 = cA + (size_t)(t + 1) * kstep;
            const char* a2 = last ? nA : cA + (size_t)(t + 2) * kstep; const char* b2 = last ? nB : cB + (size_t)(t + 2) * kstep;
            const char* a3 = a2 + kstep; const char* b3 = b2 + kstep;
            if (last && has_next) S.a_ready(nxt);
            if constexpr (SP2) {
            PG8_LDB(B0, 0, 0); PG8_LDB(B1, 0, 1); PG8_SCHED; PG8_LDA(At, 0, 0); PG8_STAGE(PG8_SA(1, 1), a1 + hstep, voffA);
            PG8_WAIT_V(8); PG8_WAIT_L(0); PG8_BAR; PG8_MMA(0, 0, At, B0); PG8_MMA(0, 1, At, B1); PG8_BAR; PG8_SCHED;
            PG8_LDA(At, 0, 1); PG8_STAGE(PG8_SB(0, 0), b2, voffB); PG8_STAGE(PG8_SB(0, 1), b2 + hstep, voffB); PG8_STAGE(PG8_SA(0, 0), a2, voffA);
            PG8_WAIT_V(8); PG8_WAIT_L(0); PG8_BAR; PG8_MMA(1, 0, At, B0); PG8_MMA(1, 1, At, B1); PG8_BAR; PG8_SCHED;
            PG8_LDB(B0, 1, 0); PG8_LDB(B1, 1, 1); PG8_SCHED; PG8_LDA(At, 1, 0); PG8_STAGE(PG8_SA(0, 1), a2 + hstep, voffA);
            PG8_WAIT_V(8); PG8_WAIT_L(0); PG8_BAR; PG8_MMA(0, 0, At, B0); PG8_MMA(0, 1, At, B1); PG8_BAR; PG8_SCHED;
            PG8_LDA(At, 1, 1); PG8_STAGE(PG8_SB(1, 0), b3, voffB); PG8_STAGE(PG8_SB(1, 1), b3 + hstep, voffB); PG8_STAGE(PG8_SA(1, 0), a3, voffA);
            PG8_WAIT_V(8); PG8_WAIT_L(0); PG8_BAR; PG8_MMA(1, 0, At, B0); PG8_MMA(1, 1, At, B1); PG8_BAR; PG8_SCHED;
            } else {
            PG8_LDB(B0, 0, 0); PG8_SCHED; PG8_LDA(At, 0, 0); PG8_STAGE(PG8_SA(1, 1), a1 + hstep, voffA);
            PG8_WAIT_L(8); PG8_BAR; PG8_WAIT_L(0); PG8_MMA(0, 0, At, B0); PG8_BAR; PG8_SCHED;
            PG8_LDB(B1, 0, 1); PG8_STAGE(PG8_SB(0, 0), b2, voffB);
            PG8_BAR; PG8_WAIT_L(0); PG8_MMA(0, 1, At, B1); PG8_BAR;
            PG8_LDA(At, 0, 1); PG8_STAGE(PG8_SA(0, 0), a2, voffA);
            PG8_BAR; PG8_WAIT_L(0); PG8_MMA(1, 0, At, B0); PG8_BAR; PG8_SCHED;
            PG8_STAGE(PG8_SB(0, 1), b2 + hstep, voffB);
            PG8_WAIT_V(6); PG8_BAR; PG8_MMA(1, 1, At, B1); PG8_BAR;
            PG8_LDB(B0, 1, 0); PG8_SCHED; PG8_LDA(At, 1, 0); PG8_STAGE(PG8_SA(0, 1), a2 + hstep, voffA);
            PG8_WAIT_L(8); PG8_BAR; PG8_WAIT_L(0); PG8_MMA(0, 0, At, B0); PG8_BAR; PG8_SCHED;
            PG8_LDB(B1, 1, 1); PG8_STAGE(PG8_SB(1, 0), b3, voffB);
            PG8_BAR; PG8_WAIT_L(0); PG8_MMA(0, 1, At, B1); PG8_BAR;
            PG8_LDA(At, 1, 1); PG8_STAGE(PG8_SA(1, 0), a3, voffA);
            PG8_BAR; PG8_WAIT_L(0); PG8_MMA(1, 0, At, B0); PG8_BAR; PG8_SCHED;
            PG8_STAGE(PG8_SB(1, 1), b3 + hstep, voffB);
            PG8_WAIT_V(6); PG8_BAR; PG8_MMA(1, 1, At, B1); PG8_BAR;
            }
        }
        if constexpr (ALIGN_EPI) { if (wr == 0) PG8_BAR; }
        if constexpr (!Epi::AFTER_DRAIN) { E(acc, cur, wr, wc, fr, fq); S.done(cur); }
        if (!has_next) break;
#pragma unroll
        for (int a = 0; a < 2; ++a)
#pragma unroll
            for (int b = 0; b < 2; ++b)
#pragma unroll
                for (int m = 0; m < 4; ++m)
#pragma unroll
                    for (int n = 0; n < 2; ++n) acc[a][b][m][n] = (f32x4){0.f, 0.f, 0.f, 0.f};
        cur = nxt; cA = nA; cB = nB; ++ui;
        if constexpr (ALIGN_EPI) { if (wr == 1) PG8_BAR; }
    }
    PG8_WAIT_V(0);
    if constexpr (!ALIGN_EPI) { if (wr == 0) PG8_BAR; }
    PG8_BAR;
    if constexpr (Epi::AFTER_DRAIN) { E.fused(acc, cur, wr, wc, fr, fq, lds, wid, lane); S.done(cur); }
#undef PG8_SA
#undef PG8_SB
#undef PG8_STAGE
#undef PG8_LDA
#undef PG8_LDB
#undef PG8_MMA
#undef PG8_WAIT_V
#undef PG8_WAIT_L
#undef PG8_BAR
#undef PG8_SCHED
}
}

#define LAS __attribute__((address_space(3)))
typedef unsigned short bf16_t;
typedef unsigned v4u __attribute__((ext_vector_type(4)));
typedef unsigned v2u __attribute__((ext_vector_type(2)));
typedef float f32x4 __attribute__((ext_vector_type(4)));
constexpr int NT = 512, NWAVES = 8;
constexpr int BATCH = 4, SEQ = 4096, DM = 1024, MROWS = BATCH * SEQ, DPROJ = 2304, DFF = 2816, PLE = 256, DEPTH = 4;
constexpr float EPS = 1e-6f;
constexpr int LDS_BYTES = 147456;
constexpr size_t MiB = 1u << 20;
constexpr size_t WS_WIN = 1 * MiB, WS_WOUT = 6 * MiB, WS_WUP = 8 * MiB, WS_WDN = 19 * MiB, WS_WPG = 25 * MiB, WS_WPE = 27 * MiB;
constexpr size_t WS_RGA = 28 * MiB, WS_RGH = 28 * MiB + 512 * 1024, WS_CARRY = 29 * MiB, WS_DEC = 30 * MiB;
constexpr size_t WS_H = 32 * MiB, WS_PBF = 64 * MiB, WS_ACT = 160 * MiB  , WS_HF = 160 * MiB;
constexpr size_t WS_Z = 160 * MiB, WS_MIX = 232 * MiB, WS_ST = 264 * MiB, WS_HL = 280 * MiB, WS_CA = 288 * MiB;
constexpr size_t WS_WSM = 27 * MiB + 512 * 1024, WS_WAT = WS_WSM + 128 * 1024, WS_WXT = WS_WAT + 32 * 1024, WS_WDT = WS_WXT + 32 * 1024, WS_STB = 296 * MiB;
constexpr size_t WS_SS = 336 * MiB, WS_XB1 = 304 * MiB;
constexpr size_t WS_PE = 72 * MiB;
constexpr size_t WS_END = 349 * MiB;

__device__ __forceinline__ float bf2f(bf16_t v) { return __uint_as_float(((unsigned)v) << 16); }
__device__ __forceinline__ float bflo(unsigned w) { return __uint_as_float(w << 16); }
__device__ __forceinline__ float bfhi(unsigned w) { return __uint_as_float(w & 0xffff0000u); }
__device__ __forceinline__ unsigned pk2(float lo, float hi) { unsigned r; asm("v_cvt_pk_bf16_f32 %0, %1, %2" : "=v"(r) : "v"(lo), "v"(hi)); return r; }
__device__ __forceinline__ unsigned f2bf(float f) { return pk2(f, f) & 0xffffu; }
__device__ __forceinline__ float frcp(float x) { return __builtin_amdgcn_rcpf(x); }
__device__ __forceinline__ float sigm(float x) { return frcp(1.f + __builtin_amdgcn_exp2f(-1.4426950408889634f * x)); }
__device__ __forceinline__ float gelu_t(float x) { return x * frcp(1.f + __builtin_amdgcn_exp2f(x * (-2.3022081980f + -0.1029432398f * (x * x)))); }
__device__ __forceinline__ float silu_(float x) { return x * frcp(1.f + __builtin_amdgcn_exp2f(-1.4426950408889634f * x)); }
__device__ __forceinline__ float wave_sum(float v) {
#pragma unroll
    for (int o = 1; o < 64; o <<= 1) v += __shfl_xor(v, o);
    return v;
}
#define LDS_WAIT() asm volatile("s_waitcnt lgkmcnt(0)" ::: "memory")

struct Params { const float* in[29]; float* out; unsigned char* ws; };

__device__ __forceinline__ void transpose_item(const float* W, int K, int N, bf16_t* WT, LAS float* scr, int item, int lane, const float* gk, bool ffn_perm = false) {
    const int nblk = N / 32, kb = item / nblk, nb = item % nblk, k0 = 64 * kb, n0 = 32 * nb;
    float wreg[32];
#pragma unroll
    for (int i = 0; i < 32; ++i) wreg[i] = __builtin_nontemporal_load(&W[(size_t)(k0 + 2 * i + (lane >> 5)) * N + n0 + (lane & 31)]);
#pragma unroll
    for (int i = 0; i < 32; ++i) scr[(2 * i + (lane >> 5)) * 33 + (lane & 31)] = wreg[i];
    LDS_WAIT(); asm volatile("" ::: "memory");
    const int c = lane & 7;
#pragma unroll
    for (int j = 0; j < 4; ++j) { const int n = (lane >> 3) + 8 * j; const LAS float* s = scr + (8 * c) * 33 + n;
        f32x4 ga = {1.f, 1.f, 1.f, 1.f}, gb = {1.f, 1.f, 1.f, 1.f}; if (gk) { ga = *(const f32x4*)(gk + k0 + 8 * c); gb = *(const f32x4*)(gk + k0 + 8 * c + 4); }
        v4u o; o.x = pk2(s[0 * 33] * ga.x, s[1 * 33] * ga.y); o.y = pk2(s[2 * 33] * ga.z, s[3 * 33] * ga.w); o.z = pk2(s[4 * 33] * gb.x, s[5 * 33] * gb.y); o.w = pk2(s[6 * 33] * gb.z, s[7 * 33] * gb.w);
        int nr = n0 + n; if (ffn_perm) { const int hv = nr / DFF, cc = nr % DFF; nr = (cc >> 7) * 256 + hv * 128 + (cc & 127); }
        *(v4u*)(WT + (size_t)nr * K + k0 + 8 * c) = o; }
    LDS_WAIT(); asm volatile("" ::: "memory");
}

typedef short bf16x8 __attribute__((ext_vector_type(8)));
#define MFMA16(a, b, c) __builtin_amdgcn_mfma_f32_16x16x32_bf16((a), (b), (c), 0, 0, 0)
__device__ __forceinline__ bf16x8 ldsfrag(const LAS bf16_t* base, int row, int pitch, int k) { return *(const LAS bf16x8*)(base + row * pitch + k); }

__device__ __forceinline__ void gmlp2_unit(const Params& P, int l, int unit, LAS unsigned char* lds, int tid) {
    const int lane = tid & 63, wave = __builtin_amdgcn_readfirstlane(tid >> 6), lr = lane & 15, lq = lane >> 4;
    const int hp = unit & 1, n = (unit >> 1) & 31, b = unit >> 6; const size_t row0 = (size_t)b * SEQ + n * 128;
    LAS bf16_t* vnT = (LAS bf16_t*)lds;
    const bf16_t* Z = (const bf16_t*)(P.ws + WS_Z); bf16_t* MIX = (bf16_t*)(P.ws + WS_MIX); const bf16_t* WSM = (const bf16_t*)(P.ws + WS_WSM);
    const float* bs = P.in[7] + l * 4 * 128;
    {
        const f32x4 g4 = ((const f32x4*)(P.in[4] + l * 256))[lane], b4 = ((const f32x4*)(P.in[5] + l * 256))[lane];
        v2u raw[16];
#pragma unroll
        for (int tt = 0; tt < 16; ++tt) raw[tt] = *(const v2u*)(Z + (row0 + wave * 16 + tt) * DPROJ + 256 + lane * 4);
        __builtin_amdgcn_sched_barrier(0);
        unsigned pk[4][8];
#pragma unroll
        for (int hb = 0; hb < 2; ++hb) {
            float s1[8], s2[8];
#pragma unroll
            for (int t8 = 0; t8 < 8; ++t8) { const int tt = hb * 8 + t8; const float v0 = gelu_t(bflo(raw[tt].x)), v1 = gelu_t(bfhi(raw[tt].x)), v2 = gelu_t(bflo(raw[tt].y)), v3 = gelu_t(bfhi(raw[tt].y));
                raw[tt].x = pk2(v0, v1); raw[tt].y = pk2(v2, v3);
                const float w0 = bflo(raw[tt].x), w1 = bfhi(raw[tt].x), w2 = bflo(raw[tt].y), w3 = bfhi(raw[tt].y);
                s1[t8] = (w0 + w1) + (w2 + w3); s2[t8] = (w0 * w0 + w1 * w1) + (w2 * w2 + w3 * w3); }
#pragma unroll
            for (int o = 1; o < 64; o <<= 1) {
#pragma unroll
                for (int t8 = 0; t8 < 8; ++t8) { s1[t8] += __shfl_xor(s1[t8], o); s2[t8] += __shfl_xor(s2[t8], o); } }
#pragma unroll
            for (int t8 = 0; t8 < 8; ++t8) { const int tt = hb * 8 + t8;
                const float mu = s1[t8] * (1.f / 256.f); const float var = fmaxf(s2[t8] * (1.f / 256.f) - mu * mu, 0.f); const float rstd = rsqrtf(var + EPS);
                const float v0 = bflo(raw[tt].x) - mu, v1 = bfhi(raw[tt].x) - mu, v2 = bflo(raw[tt].y) - mu, v3 = bfhi(raw[tt].y) - mu;
                const unsigned o0 = f2bf(v0 * rstd * g4.x + b4.x), o1 = f2bf(v1 * rstd * g4.y + b4.y), o2 = f2bf(v2 * rstd * g4.z + b4.z), o3 = f2bf(v3 * rstd * g4.w + b4.w);
                if (tt & 1) { pk[0][tt >> 1] |= o0 << 16; pk[1][tt >> 1] |= o1 << 16; pk[2][tt >> 1] |= o2 << 16; pk[3][tt >> 1] |= o3 << 16; }
                else { pk[0][tt >> 1] = o0; pk[1][tt >> 1] = o1; pk[2][tt >> 1] = o2; pk[3][tt >> 1] = o3; }
            }
            asm volatile("" ::: "memory");
        }
        if ((lane >> 5) == hp) {
#pragma unroll
            for (int i = 0; i < 4; ++i) { LAS v4u* dst = (LAS v4u*)(vnT + ((lane & 31) * 4 + i) * 136 + wave * 16);
                dst[0] = (v4u){pk[i][0], pk[i][1], pk[i][2], pk[i][3]}; dst[1] = (v4u){pk[i][4], pk[i][5], pk[i][6], pk[i][7]}; }
        }
    }
    __syncthreads();
    const int t0 = wave * 16, nks = (wave >> 1) + 1;
#pragma unroll
    for (int hl = 0; hl < 2; ++hl) {
        const int h = hp * 2 + hl;
        f32x4 acc[4];
#pragma unroll
        for (int nt = 0; nt < 4; ++nt) acc[nt] = (f32x4){0.f, 0.f, 0.f, 0.f};
        float uu[4][4];
#pragma unroll
        for (int nt = 0; nt < 4; ++nt)
#pragma unroll
            for (int jj = 0; jj < 4; ++jj) uu[nt][jj] = bf2f(Z[(row0 + t0 + lq * 4 + jj) * DPROJ + h * 64 + nt * 16 + lr]);
        float bsv4[4];
#pragma unroll
        for (int jj = 0; jj < 4; ++jj) bsv4[jj] = bs[h * 128 + t0 + lq * 4 + jj];
        bf16x8 af[4];
#pragma unroll
        for (int ks = 0; ks < 4; ++ks) af[ks] = *(const bf16x8*)(WSM + ((size_t)(h * 128 + t0 + lr)) * 128 + (ks < nks ? ks : 0) * 32 + lq * 8);
        __builtin_amdgcn_sched_barrier(0);
#pragma unroll
        for (int ks = 0; ks < 4; ++ks) if (ks < nks) {
#pragma unroll
            for (int nt = 0; nt < 4; ++nt) acc[nt] = MFMA16(af[ks], ldsfrag(vnT, hl * 64 + nt * 16 + lr, 136, ks * 32 + lq * 8), acc[nt]);
        }
#pragma unroll
        for (int jj = 0; jj < 4; ++jj) { const int t = t0 + lq * 4 + jj; const float bsv = bsv4[jj];
#pragma unroll
            for (int nt = 0; nt < 4; ++nt) MIX[(row0 + t) * DM + h * 64 + nt * 16 + lr] = (bf16_t)f2bf(gelu_t(uu[nt][jj]) * (acc[nt][jj] + bsv)); }
    }
    __syncthreads();
}

__device__ __forceinline__ void pool2_unit(const Params& P, int l, int unit, LAS unsigned char* lds, int tid) {
    const int lane = tid & 63, wave = __builtin_amdgcn_readfirstlane(tid >> 6), lr = lane & 15, lq = lane >> 4;
    const int b = unit >> 6, n = unit & 63; const size_t row0 = (size_t)b * SEQ + n * 64;
    LAS float* raw = (LAS float*)lds;
    LAS bf16_t* plB = (LAS bf16_t*)(lds + 79 * 256 * 4);
    const bf16_t* Z = (const bf16_t*)(P.ws + WS_Z); bf16_t* MIX = (bf16_t*)(P.ws + WS_MIX); const bf16_t* WDT = (const bf16_t*)(P.ws + WS_WDT);
    { const int c = tid & 255, half = tid >> 8; bf16_t rv[40];
      const bf16_t* zc = Z + ((size_t)b * SEQ) * DPROJ + 2048 + c;
#pragma unroll
      for (int i = 0; i < 40; ++i) { int r = half + 2 * i; r = r < 79 ? r : 78; int tp = n * 64 - 15 + r; tp = tp >= 0 ? tp : 0; rv[i] = zc[(size_t)tp * DPROJ]; }
      __builtin_amdgcn_sched_barrier(0);
#pragma unroll
      for (int i = 0; i < 40; ++i) { const int r = half + 2 * i; if (r < 79) raw[r * 256 + c] = (n * 64 - 15 + r >= 0) ? bf2f(rv[i]) : 0.f; } }
    __syncthreads();
    { const int c = tid & 255, half = tid >> 8, w = 2 << (c >> 6), tb = half * 32;
      float s = 0.f; for (int j = 1; j < w; ++j) s += raw[(15 + tb - j) * 256 + c];
#pragma unroll 8
      for (int i = 0; i < 32; ++i) { const int t = tb + i; const float cur = raw[(15 + t) * 256 + c]; s += cur;
          const int pos1 = n * 64 + t + 1; const float cnt = (float)(pos1 < w ? pos1 : w);
          plB[t * 264 + c] = (bf16_t)f2bf(s * frcp(cnt) - cur);
          s -= raw[(15 + t - w + 1) * 256 + c]; } }
    __syncthreads();
    const int g = wave >> 1, ntp = wave & 1;
    bf16x8 Bf[2][2];
#pragma unroll
    for (int n2 = 0; n2 < 2; ++n2)
#pragma unroll
        for (int ks = 0; ks < 2; ++ks) Bf[n2][ks] = *(const bf16x8*)(WDT + ((size_t)(g * 64 + (ntp * 2 + n2) * 16 + lr)) * 64 + ks * 32 + lq * 8);
    float sc[2];
#pragma unroll
    for (int n2 = 0; n2 < 2; ++n2) sc[n2] = P.in[18][l * 256 + g * 64 + (ntp * 2 + n2) * 16 + lr];
#pragma unroll
    for (int mt = 0; mt < 4; ++mt) {
        f32x4 acc[2] = {(f32x4){0.f, 0.f, 0.f, 0.f}, (f32x4){0.f, 0.f, 0.f, 0.f}};
#pragma unroll
        for (int ks = 0; ks < 2; ++ks) { const bf16x8 a = ldsfrag(plB, mt * 16 + lr, 264, g * 64 + ks * 32 + lq * 8);
#pragma unroll
            for (int n2 = 0; n2 < 2; ++n2) acc[n2] = MFMA16(a, Bf[n2][ks], acc[n2]); }
#pragma unroll
        for (int n2 = 0; n2 < 2; ++n2)
#pragma unroll
            for (int jj = 0; jj < 4; ++jj) MIX[(row0 + mt * 16 + lq * 4 + jj) * DM + 768 + g * 64 + (ntp * 2 + n2) * 16 + lr] = (bf16_t)f2bf(acc[n2][jj] * sc[n2]);
    }
    __syncthreads();
}

__device__ __forceinline__ void rglru2_unit(const Params& P, int l, int unit, LAS unsigned char* lds, int tid) {
    const int lane = tid & 63, wave = __builtin_amdgcn_readfirstlane(tid >> 6), lr = lane & 15, lq = lane >> 4;
    const int b = unit >> 6, k = unit & 63; const size_t row0 = (size_t)b * SEQ + k * 64;
    LAS float* xcF = (LAS float*)lds;
    LAS bf16_t* xcB = (LAS bf16_t*)(lds + 64 * 256 * 4);
    const bf16_t* Z = (const bf16_t*)(P.ws + WS_Z);
    bf16_t* HL = (bf16_t*)(P.ws + WS_HL); bf16_t* CA = (bf16_t*)(P.ws + WS_CA);
    float* RGA = (float*)(P.ws + WS_RGA); float* RGH = (float*)(P.ws + WS_RGH);
    const bf16_t* WAT = (const bf16_t*)(P.ws + WS_WAT); const bf16_t* WXT = (const bf16_t*)(P.ws + WS_WXT);
    {
        const int c = tid & 255, half = tid >> 8, tp0 = k * 64 + half * 32;
        const float* cwp = P.in[8] + (size_t)l * 4 * 256 + c;
        const float cw0 = cwp[0], cw1 = cwp[256], cw2 = cwp[512], cw3 = cwp[768], cb = P.in[9][l * 256 + c];
        const bf16_t* zb = Z + ((size_t)b * SEQ) * DPROJ + 512 + c;
        float xr[35];
#pragma unroll
        for (int i = 0; i < 35; ++i) { const int tp = tp0 - 3 + i; xr[i] = __uint_as_float((unsigned)zb[(size_t)(tp >= 0 ? tp : 0) * DPROJ] << 16); }
        __builtin_amdgcn_sched_barrier(0);
#pragma unroll
        for (int i = 0; i < 3; ++i) { asm volatile("" : "+v"(xr[i])); xr[i] = (tp0 - 3 + i >= 0) ? xr[i] : 0.f; }
#pragma unroll
        for (int tt = 0; tt < 32; ++tt) { const float xc = cb + cw0 * xr[tt] + cw1 * xr[tt + 1] + cw2 * xr[tt + 2] + cw3 * xr[tt + 3];
            xcF[(half * 32 + tt) * 256 + c] = xc; xcB[(half * 32 + tt) * 264 + c] = (bf16_t)f2bf(xc); }
    }
    __syncthreads();
    const int h = wave >> 1, ntp = wave & 1;
    bf16x8 Ba[2][2], Bx[2][2];
#pragma unroll
    for (int n2 = 0; n2 < 2; ++n2)
#pragma unroll
        for (int ks = 0; ks < 2; ++ks) { const size_t off = ((size_t)(h * 64 + (ntp * 2 + n2) * 16 + lr)) * 64 + ks * 32 + lq * 8;
            Ba[n2][ks] = *(const bf16x8*)(WAT + off); Bx[n2][ks] = *(const bf16x8*)(WXT + off); }
    float carryH[2] = {0.f, 0.f}, carryA[2] = {1.f, 1.f};
    float ba[2], bx[2], sp[2];
#pragma unroll
    for (int n2 = 0; n2 < 2; ++n2) { const int c = h * 64 + (ntp * 2 + n2) * 16 + lr; ba[n2] = P.in[11][l * 256 + c]; bx[n2] = P.in[13][l * 256 + c]; sp[n2] = log1pf(__expf(-P.in[14][l * 256 + c])); }
#pragma unroll
    for (int mt = 0; mt < 4; ++mt) {
        float gbv[2][4];
#pragma unroll
        for (int n2 = 0; n2 < 2; ++n2)
#pragma unroll
            for (int jj = 0; jj < 4; ++jj) gbv[n2][jj] = bf2f(Z[(row0 + mt * 16 + lq * 4 + jj) * DPROJ + 768 + h * 64 + (ntp * 2 + n2) * 16 + lr]);
        f32x4 accA[2] = {(f32x4){0.f, 0.f, 0.f, 0.f}, (f32x4){0.f, 0.f, 0.f, 0.f}}, accX[2] = {(f32x4){0.f, 0.f, 0.f, 0.f}, (f32x4){0.f, 0.f, 0.f, 0.f}};
#pragma unroll
        for (int ks = 0; ks < 2; ++ks) { const bf16x8 a = ldsfrag(xcB, mt * 16 + lr, 264, h * 64 + ks * 32 + lq * 8);
#pragma unroll
            for (int n2 = 0; n2 < 2; ++n2) { accA[n2] = MFMA16(a, Ba[n2][ks], accA[n2]); accX[n2] = MFMA16(a, Bx[n2][ks], accX[n2]); } }
#pragma unroll
        for (int n2 = 0; n2 < 2; ++n2) {
            const int c = h * 64 + (ntp * 2 + n2) * 16 + lr;
            float aloc[4], hloc[4]; float hrun = 0.f, cum = 1.f;
#pragma unroll
            for (int jj = 0; jj < 4; ++jj) { const int t = mt * 16 + lq * 4 + jj;
                const float r = sigm(accA[n2][jj] + ba[n2]), ig = sigm(accX[n2][jj] + bx[n2]); const float la = -8.f * r * sp[n2]; const float a = __expf(la);
                const float x2 = 2.f * la; const float m2 = (x2 > -0.02f) ? -(x2 * (1.f + x2 * (0.5f + x2 * (0.16666667f + x2 * 0.041666668f)))) : 1.f - a * a;
                const float bt = __builtin_amdgcn_sqrtf(m2) * ig * xcF[t * 256 + c]; hrun = a * hrun + bt; cum *= a; hloc[jj] = hrun; aloc[jj] = cum; }
            float Ae = cum, He = hrun;
            { const float A1 = __shfl_up(Ae, 16), H1 = __shfl_up(He, 16); if (lq >= 1) { He = Ae * H1 + He; Ae = Ae * A1; } }
            { const float A2 = __shfl_up(Ae, 32), H2 = __shfl_up(He, 32); if (lq >= 2) { He = Ae * H2 + He; Ae = Ae * A2; } }
            float Ax = __shfl_up(Ae, 16), Hx = __shfl_up(He, 16); if (lq == 0) { Ax = 1.f; Hx = 0.f; }
            const float Hs = Ax * carryH[n2] + Hx, As = carryA[n2] * Ax;
            const float Ab = __shfl(Ae, 48 + lr), Hb = __shfl(He, 48 + lr);
            carryH[n2] = Ab * carryH[n2] + Hb; carryA[n2] = carryA[n2] * Ab;
#pragma unroll
            for (int jj = 0; jj < 4; ++jj) { const size_t r = row0 + mt * 16 + lq * 4 + jj; const float gg = gelu_t(gbv[n2][jj]);
                HL[r * 256 + c] = (bf16_t)f2bf((aloc[jj] * Hs + hloc[jj]) * gg); CA[r * 256 + c] = (bf16_t)f2bf(As * aloc[jj] * gg); }
        }
    }
    if (lq == 0) {
#pragma unroll
        for (int n2 = 0; n2 < 2; ++n2) { const int c = h * 64 + (ntp * 2 + n2) * 16 + lr; RGA[((size_t)b * 64 + k) * 256 + c] = carryA[n2]; RGH[((size_t)b * 64 + k) * 256 + c] = carryH[n2]; }
    }
    __syncthreads();
}

template <int MODE>
__device__ __forceinline__ void hgrn2_unit(const Params& P, int l, int unit, LAS unsigned char* lds, int tid) {
    const int lane = tid & 63, wave = __builtin_amdgcn_readfirstlane(tid >> 6), lr = lane & 15, lq = lane >> 4;
    const int hp = unit & 1, n = (unit >> 1) & 63, b = unit >> 7; const size_t row0 = (size_t)b * SEQ + n * 64;
    LAS float* SEG = (LAS float*)(lds + 124928);
    LAS bf16_t* K2T = (LAS bf16_t*)lds;
    LAS bf16_t* VT = (LAS bf16_t*)(lds + (MODE == 0 ? 18432 : 52224));
    LAS bf16_t* QS = (LAS bf16_t*)lds;
    LAS bf16_t* KS = (LAS bf16_t*)(lds + 17408);
    LAS bf16_t* Q2 = (LAS bf16_t*)(lds + 34816);
    LAS bf16_t* PP = (LAS bf16_t*)(lds + 70656) + wave * 16 * 72;
    const bf16_t* Z = (const bf16_t*)(P.ws + WS_Z); bf16_t* MIX = (bf16_t*)(P.ws + WS_MIX);
    {
        const int c = tid & 127, sg = tid >> 7, ch = hp * 128 + c;
        float lb;
        { const float* clb = P.in[15] + ch; const float c0 = clb[0], c1 = clb[256], c2 = clb[512], c3 = clb[768];
          const float mx = fmaxf(fmaxf(c0, c1), fmaxf(c2, c3)); const float e0 = __expf(c0 - mx), e1 = __expf(c1 - mx), e2 = __expf(c2 - mx), e3 = __expf(c3 - mx);
          const float num = (l >= 1 ? e1 : 0.f) + (l >= 2 ? e2 : 0.f) + (l >= 3 ? e3 : 0.f); lb = num / (e0 + e1 + e2 + e3); }
        const bf16_t* zr = Z + (row0 + sg * 16) * DPROJ + 1024 + ch;
        float fr[16], iv[16], qv[16];
#pragma unroll
        for (int j = 0; j < 16; ++j) { fr[j] = bf2f(zr[(size_t)j * DPROJ + 256]); iv[j] = bf2f(zr[(size_t)j * DPROJ + 512]); if (MODE == 1) qv[j] = bf2f(zr[(size_t)j * DPROJ]); }
        float pre[16], kf[16]; float run = 0.f;
#pragma unroll
        for (int j = 0; j < 16; ++j) { const float fg = lb + (1.f - lb) * sigm(fr[j]); kf[j] = 1.f - fg; run += __logf(fg); pre[j] = run; }
        SEG[sg * 128 + c] = run;
        __syncthreads();
        const float s0 = SEG[c], s1 = SEG[128 + c], s2 = SEG[256 + c], s3 = SEG[384 + c];
        const float off = (sg >= 1 ? s0 : 0.f) + (sg >= 2 ? s1 : 0.f) + (sg >= 3 ? s2 : 0.f);
        const float bm = s0 + s1, bl = (s0 + s1) + (s2 + s3);
        unsigned pv[8], pk2_[8];
#pragma unroll
        for (int j = 0; j < 16; ++j) {
            const float bb = off + pre[j]; const int t = sg * 16 + j;
            const unsigned vb = f2bf(iv[j]);
            if (j & 1) pv[j >> 1] |= vb << 16; else pv[j >> 1] = vb;
            if (MODE == 0) { const unsigned kb = f2bf(kf[j] * __expf(bl - bb)); if (j & 1) pk2_[j >> 1] |= kb << 16; else pk2_[j >> 1] = kb; }
            else { const float q = silu_(qv[j]);
                QS[t * 136 + c] = (bf16_t)f2bf(q * __expf(bb - bm)); KS[t * 136 + c] = (bf16_t)f2bf(kf[j] * __expf(bm - bb)); Q2[t * 136 + c] = (bf16_t)f2bf(q * __expf(bb)); }
        }
        { LAS v4u* dst = (LAS v4u*)(VT + c * 72 + sg * 16); dst[0] = (v4u){pv[0], pv[1], pv[2], pv[3]}; dst[1] = (v4u){pv[4], pv[5], pv[6], pv[7]}; }
        if (MODE == 0) { LAS v4u* dst = (LAS v4u*)(K2T + c * 72 + sg * 16); dst[0] = (v4u){pk2_[0], pk2_[1], pk2_[2], pk2_[3]}; dst[1] = (v4u){pk2_[4], pk2_[5], pk2_[6], pk2_[7]};
            if (sg == 0) { const int bh = b * 4 + hp * 2 + (c >> 6); ((float*)(P.ws + WS_DEC))[((size_t)bh * 64 + n) * 64 + (c & 63)] = __expf(bl); } }
    }
    __syncthreads();
    const int hl = wave >> 2, w4 = wave & 3, bh = b * 4 + hp * 2 + hl, h = hp * 2 + hl;
    if (MODE == 0) {
        float* ST = (float*)(P.ws + WS_ST) + ((size_t)bh * 64 + n) * 4096;
        f32x4 acc[4];
#pragma unroll
        for (int dt = 0; dt < 4; ++dt) acc[dt] = (f32x4){0.f, 0.f, 0.f, 0.f};
#pragma unroll
        for (int ks = 0; ks < 2; ++ks) { const bf16x8 a = ldsfrag(VT, hl * 64 + w4 * 16 + lr, 72, ks * 32 + lq * 8);
#pragma unroll
            for (int dt = 0; dt < 4; ++dt) acc[dt] = MFMA16(a, ldsfrag(K2T, hl * 64 + dt * 16 + lr, 72, ks * 32 + lq * 8), acc[dt]); }
#pragma unroll
        for (int dt = 0; dt < 4; ++dt)
#pragma unroll
            for (int jj = 0; jj < 4; ++jj) ST[(w4 * 16 + lq * 4 + jj) * 64 + dt * 16 + lr] = acc[dt][jj];
    } else {
        const int mt = w4;
        const bf16_t* STB = (const bf16_t*)(P.ws + WS_STB) + ((size_t)bh * 64 + n) * 4096;
        bf16x8 Sf[4][2];
#pragma unroll
        for (int nt = 0; nt < 4; ++nt)
#pragma unroll
            for (int ks = 0; ks < 2; ++ks) Sf[nt][ks] = *(const bf16x8*)(STB + (nt * 16 + lr) * 64 + ks * 32 + lq * 8);
        float gv[4][4];
#pragma unroll
        for (int nt = 0; nt < 4; ++nt)
#pragma unroll
            for (int jj = 0; jj < 4; ++jj) gv[nt][jj] = bf2f(Z[(row0 + mt * 16 + lq * 4 + jj) * DPROJ + 1792 + h * 64 + nt * 16 + lr]);
        float ng[4];
#pragma unroll
        for (int nt = 0; nt < 4; ++nt) ng[nt] = P.in[16][l * 64 + nt * 16 + lr];
        const bf16x8 qa0 = ldsfrag(QS, mt * 16 + lr, 136, hl * 64 + lq * 8), qa1 = ldsfrag(QS, mt * 16 + lr, 136, hl * 64 + 32 + lq * 8);
#pragma unroll
        for (int st = 0; st < 4; ++st) {
            f32x4 s = (f32x4){0.f, 0.f, 0.f, 0.f};
            if (st <= mt) { s = MFMA16(qa0, ldsfrag(KS, st * 16 + lr, 136, hl * 64 + lq * 8), s); s = MFMA16(qa1, ldsfrag(KS, st * 16 + lr, 136, hl * 64 + 32 + lq * 8), s); }
#pragma unroll
            for (int jj = 0; jj < 4; ++jj) { const bool keep = (st < mt) || (st == mt && lr <= lq * 4 + jj); PP[(lq * 4 + jj) * 72 + st * 16 + lr] = (bf16_t)f2bf(keep ? s[jj] : 0.f); }
        }
        f32x4 acc[4];
#pragma unroll
        for (int nt = 0; nt < 4; ++nt) acc[nt] = (f32x4){0.f, 0.f, 0.f, 0.f};
        const bf16x8 q20 = ldsfrag(Q2, mt * 16 + lr, 136, hl * 64 + lq * 8), q21 = ldsfrag(Q2, mt * 16 + lr, 136, hl * 64 + 32 + lq * 8);
#pragma unroll
        for (int nt = 0; nt < 4; ++nt) { acc[nt] = MFMA16(q20, Sf[nt][0], acc[nt]); acc[nt] = MFMA16(q21, Sf[nt][1], acc[nt]); }
#pragma unroll
        for (int ks = 0; ks < 2; ++ks) if (ks * 2 <= mt) { const bf16x8 pa = ldsfrag(PP, lr, 72, ks * 32 + lq * 8);
#pragma unroll
            for (int nt = 0; nt < 4; ++nt) acc[nt] = MFMA16(pa, ldsfrag(VT, hl * 64 + nt * 16 + lr, 72, ks * 32 + lq * 8), acc[nt]); }
#pragma unroll
        for (int jj = 0; jj < 4; ++jj) {
            float ss = (acc[0][jj] * acc[0][jj] + acc[1][jj] * acc[1][jj]) + (acc[2][jj] * acc[2][jj] + acc[3][jj] * acc[3][jj]);
            ss += __shfl_xor(ss, 1); ss += __shfl_xor(ss, 2); ss += __shfl_xor(ss, 4); ss += __shfl_xor(ss, 8);
            const float rstd = rsqrtf(ss * (1.f / 64.f) + EPS);
#pragma unroll
            for (int nt = 0; nt < 4; ++nt) MIX[(row0 + mt * 16 + lq * 4 + jj) * DM + 512 + h * 64 + nt * 16 + lr] = (bf16_t)f2bf(acc[nt][jj] * rstd * ng[nt] * silu_(gv[nt][jj]));
        }
    }
    __syncthreads();
}

#define RLX_AGENT __ATOMIC_RELAXED, __HIP_MEMORY_SCOPE_AGENT
#define XB_TMO      128
#define XB_XCNT(j)  (256  + 64 * (j))
#define XB_XSUB(j)  (1280 + 64 * (j))
#define XB_XGEN(j)  (2304 + 64 * (j))
#define XB_TOP      3328
#define XB_TOPGEN   3392
#define XCD_BAR_WORDS 3456
#define XB_SPIN_CAP (1u << 18)

__device__ __forceinline__ unsigned xb_ld(unsigned* p)              { return __hip_atomic_load(p, __ATOMIC_RELAXED, __HIP_MEMORY_SCOPE_AGENT); }
__device__ __forceinline__ unsigned xb_add(unsigned* p, unsigned v) { return __hip_atomic_fetch_add(p, v, __ATOMIC_RELAXED, __HIP_MEMORY_SCOPE_AGENT); }
__device__ __forceinline__ unsigned xb_xcc_id() { return (unsigned)__builtin_amdgcn_s_getreg((3 << 11) | 20) & 0xFu; }
#define XB_SPIN(cond, bar) do { unsigned _sp = 0; while (cond) { __builtin_amdgcn_s_sleep(1); \
    if ((++_sp & 255u) == 0u) { if (xb_ld(&(bar)[XB_TMO])) break; if (_sp > XB_SPIN_CAP) { atomicAdd(&(bar)[XB_TMO], 1u); break; } } } } while (0)

struct XcdBarrier {
    unsigned* bar; unsigned x;
    volatile LAS unsigned* st;
};

__device__ __forceinline__ XcdBarrier xcd_barrier_post(unsigned* bar, volatile LAS unsigned* st) {
    XcdBarrier b; b.bar = bar; b.x = xb_xcc_id(); b.st = st;
    if (threadIdx.x == 0) (void)xb_add(&bar[XB_XCNT(b.x)], 1u);
    return b;
}
__device__ __forceinline__ void xcd_barrier_complete(unsigned* bar, unsigned x, unsigned& nloc, unsigned& nx) {
    const unsigned G = gridDim.x * gridDim.y * gridDim.z;
    unsigned sum, cnt, mine, sp = 0u;
    for (;;) {
        sum = 0u; cnt = 0u; mine = 0u;
#pragma unroll
        for (unsigned j = 0; j < 16; ++j) { const unsigned c = xb_ld(&bar[XB_XCNT(j)]); sum += c; cnt += (c > 0u) ? 1u : 0u; mine = (j == x) ? c : mine; }
        if (sum == G) break;
        __builtin_amdgcn_s_sleep(1);
        if ((++sp & 255u) == 0u) { if (xb_ld(&bar[XB_TMO])) break; if (sp > XB_SPIN_CAP) { atomicAdd(&bar[XB_TMO], 1u); break; } }
    }
    nloc = mine > 0u ? mine : 1u; nx = cnt > 0u ? cnt : 1u;
}

__device__ __forceinline__ void xcd_barrier(const XcdBarrier& b) {
    asm volatile("s_waitcnt vmcnt(0)" ::: "memory");
    __syncthreads();
    if (threadIdx.x == 0) {
        unsigned* bar = b.bar;
        __builtin_amdgcn_s_waitcnt(0);
        unsigned nloc = b.st[0], nx = b.st[1];
        if (nloc == 0u) { xcd_barrier_complete(bar, b.x, nloc, nx); b.st[0] = nloc; b.st[1] = nx; }
        const unsigned old = xb_add(&bar[XB_XSUB(b.x)], 1u);
        const unsigned gen = old / nloc;
        if (old + 1u == (gen + 1u) * nloc) {
            __builtin_amdgcn_fence(__ATOMIC_RELEASE, "agent");
            asm volatile("s_waitcnt vmcnt(0)" ::: "memory");
            const unsigned og = xb_add(&bar[XB_TOP], 1u);
            const unsigned tg = og / nx;
            if (og + 1u == (tg + 1u) * nx) xb_add(&bar[XB_TOPGEN], 1u);
            else XB_SPIN(xb_ld(&bar[XB_TOPGEN]) == tg, bar);
            __builtin_amdgcn_fence(__ATOMIC_ACQUIRE, "agent");
            xb_add(&bar[XB_XGEN(b.x)], 1u);
            asm volatile("s_waitcnt vmcnt(0)" ::: "memory");
        } else {
            XB_SPIN(xb_ld(&bar[XB_XGEN(b.x)]) == gen, bar);
            __builtin_amdgcn_fence(__ATOMIC_ACQUIRE, "agent");
            asm volatile("s_waitcnt vmcnt(0)" ::: "memory");
        }
    }
    __syncthreads();
}

__global__ void __launch_bounds__(NT, 2) mega_fwd(Params P) {
    extern __shared__ __attribute__((aligned(16))) unsigned char lds_raw[];
    LAS unsigned char* lds = (LAS unsigned char*)lds_raw;
    cg::grid_group grid = cg::this_grid();
    const int G = gridDim.x, bid = blockIdx.x;
    const int NGW = G * NWAVES, NTHR = G * NT;
    volatile LAS unsigned* MISC = (volatile LAS unsigned*)(lds + LDS_BYTES - 64);
    if (threadIdx.x < 16) MISC[threadIdx.x] = 0u;
    __syncthreads();
    XcdBarrier xbar = xcd_barrier_post((unsigned*)P.ws, MISC);
#define GSYNC() do { xcd_barrier(xbar); for (int r_ = 0; r_ < REP_SYNC; ++r_) xcd_barrier(xbar); } while (0)
#define TIDS int tid = threadIdx.x; asm volatile("" : "+v"(tid)); const int lane = tid & 63, wave = __builtin_amdgcn_readfirstlane(tid >> 6); const int gw = bid * NWAVES + wave, gtid = bid * NT + tid; (void)lane; (void)gw; (void)gtid;
    unsigned char* ws = P.ws;
    bf16_t* WIN = (bf16_t*)(ws + WS_WIN); bf16_t* WOUT = (bf16_t*)(ws + WS_WOUT); bf16_t* WUP = (bf16_t*)(ws + WS_WUP);
    bf16_t* WDN = (bf16_t*)(ws + WS_WDN); bf16_t* WPG = (bf16_t*)(ws + WS_WPG); bf16_t* WPE = (bf16_t*)(ws + WS_WPE);
    bf16_t* XB0 = (bf16_t*)(ws + WS_H); bf16_t* XB1 = (bf16_t*)(ws + WS_XB1); float* SS = (float*)(ws + WS_SS);
    bf16_t* PBF = (bf16_t*)(ws + WS_PBF); bf16_t* ACT = (bf16_t*)(ws + WS_ACT); bf16_t* HF = (bf16_t*)(ws + WS_HF);
    bf16_t* Zb = (bf16_t*)(ws + WS_Z); bf16_t* MIX = (bf16_t*)(ws + WS_MIX); bf16_t* PEb = (bf16_t*)(ws + WS_PE);
    float* X = P.out;

#define GEMM(Aop, Bop, Nn, Kk, MODE, Optr, LDC, SSI, SSO, XBO, XBI) do { pg8::Gemm g{Aop, Bop, MROWS, Nn, Kk, 0}; pg8::Epi<MODE> E{Optr, LDC, XBI, PEb, SSI, SSO, XBO, nullptr, nullptr, nullptr}; pg8::StaticOrder S; S.init(MROWS, Nn, G, bid); \
        pg8::gemm_phase<pg8::Epi<MODE>, pg8::StaticOrder, true, true>(lds, g, S, E); } while (0)
    for (int l_ = 0; l_ < DEPTH; ++l_) {
        {
            int l = l_; asm volatile("" : "+s"(l));
            bf16_t* XBc = XB0; bf16_t* XBn = XB1;     float* SSl = SS + (size_t)3 * l * MROWS * 16;
            for (int re_ = 0; re_ < REP_ELT; ++re_) {   TIDS
                LAS float* scr = (LAS float*)(lds + wave * 16384);
                const float* w_in = P.in[3] + (size_t)l * DM * DPROJ; const float* w_out = P.in[19] + (size_t)l * DM * DM; const float* w_up = P.in[21] + (size_t)l * DM * 2 * DFF;
                const float* w_dn = P.in[24] + (size_t)l * DFF * DM; const float* w_pe = P.in[26] + (size_t)l * PLE * DM; const float* w_pg = P.in[27] + (size_t)l * DM * DM;
                for (int it = gw; it < 6528; it += NGW) {
                    int r = it;
                    if (r < 1152) { transpose_item(w_in, DM, DPROJ, WIN, scr, r, lane, P.in[2] + l * DM); continue; } r -= 1152;
                    if (r < 512) { transpose_item(w_out, DM, DM, WOUT, scr, r, lane, nullptr); continue; } r -= 512;
                    if (r < 2816) { transpose_item(w_up, DM, 2 * DFF, WUP, scr, r, lane, P.in[20] + l * DM, true); continue; } r -= 2816;
                    if (r < 1408) { transpose_item(w_dn, DFF, DM, WDN, scr, r, lane, nullptr); continue; } r -= 1408;
                    if (r < 512) { transpose_item(w_pg, DM, DM, WPG, scr, r, lane, P.in[25] + l * DM); continue; } r -= 512;
                    transpose_item(w_pe, PLE, DM, WPE, scr, r, lane, nullptr);
                }
                const float* pl = P.in[1] + (size_t)l * MROWS * PLE;
                for (int i = gtid; i < MROWS * PLE / 8; i += NTHR) { const f32x4 a = __builtin_nontemporal_load(&((const f32x4*)pl)[2 * i]), b2 = __builtin_nontemporal_load(&((const f32x4*)pl)[2 * i + 1]);
                    v4u w; w.x = pk2(a.x, a.y); w.y = pk2(a.z, a.w); w.z = pk2(b2.x, b2.y); w.w = pk2(b2.z, b2.w); ((v4u*)PBF)[i] = w; }
                { bf16_t* WSM = (bf16_t*)(ws + WS_WSM); bf16_t* WAT = (bf16_t*)(ws + WS_WAT); bf16_t* WXT = (bf16_t*)(ws + WS_WXT); bf16_t* WDT = (bf16_t*)(ws + WS_WDT);
                  const float* aws = P.in[6] + (size_t)l * 65536; const float* bwa = P.in[10] + (size_t)l * 16384; const float* bwx = P.in[12] + (size_t)l * 16384; const float* dw = P.in[17] + (size_t)l * 16384;
                  for (int i = gtid; i < 65536 + 3 * 16384; i += NTHR) {
                      if (i < 65536) { const int t = (i >> 7) & 127, sx = i & 127; WSM[i] = (bf16_t)f2bf(sx <= t ? aws[i] : 0.f); }
                      else { const int r = i - 65536, m = r >> 14, q = r & 16383, hh = q >> 12, e = (q >> 6) & 63, d = q & 63; const int src = hh * 4096 + d * 64 + e;
                          if (m == 0) WAT[q] = (bf16_t)f2bf(bwa[src]); else if (m == 1) WXT[q] = (bf16_t)f2bf(bwx[src]); else WDT[q] = (bf16_t)f2bf(dw[src]); } } }
                if (l == 0) {
                    for (int m = gw; m < MROWS; m += NGW) {
                        const f32x4* xr = (const f32x4*)(P.in[0] + (size_t)m * DM) + lane; f32x4 v[4]; float sq = 0.f;
#pragma unroll
                        for (int j = 0; j < 4; ++j) { v[j] = xr[64 * j]; sq += (v[j].x * v[j].x + v[j].y * v[j].y) + (v[j].z * v[j].z + v[j].w * v[j].w); }
                        sq = wave_sum(sq); if (lane < 16) SS[(size_t)m * 16 + lane] = (lane == 0) ? sq : 0.f;
                        v2u* o8 = (v2u*)(XB1 + (size_t)m * DM) + lane;
#pragma unroll
                        for (int j = 0; j < 4; ++j) { v2u w; w.x = pk2(v[j].x, v[j].y); w.y = pk2(v[j].z, v[j].w); o8[64 * j] = w; }
                    }
                }
            }
            if (P.out == nullptr) grid.sync();
            GSYNC();
            GEMM(XBn, WIN, DPROJ, DM, 0, Zb, DPROJ, SSl, nullptr, nullptr, nullptr);
            {
                pg8::Gemm g{PBF, WPE, MROWS, DM, PLE, 0}; pg8::Epi<0> E{PEb, DM, nullptr, PEb, nullptr, nullptr, nullptr, nullptr, nullptr, nullptr};
                pg8::StaticOrder S; S.init(MROWS, DM, G > 64 ? G - 64 : G, G > 64 ? (bid >= 64 ? bid - 64 : (1 << 20)) : bid);
                pg8::gemm_phase<pg8::Epi<0>, pg8::StaticOrder, true, true>(lds, g, S, E); }
            GSYNC();
            for (int rm_ = 0; rm_ < REP_MIX; ++rm_) {
            {   TIDS
                for (int kk = 0; kk < 5; ++kk) {
                    const int it = (G == 256) ? bid + 256 * ((kk + bid) % 5) : -1;
                    if (it < 0) break;
                    int t2 = tid; asm volatile("" : "+v"(t2));
                    if (it < 256) gmlp2_unit(P, l, it, lds, t2);
                    else if (it < 512) pool2_unit(P, l, it - 256, lds, t2);
                    else if (it < 768) rglru2_unit(P, l, it - 512, lds, t2);
                    else hgrn2_unit<0>(P, l, it - 768, lds, t2);
                }
                if (G != 256) for (int it = bid; it < 256 + 256 + 256 + 512; it += G) {
                    int t2 = tid; asm volatile("" : "+v"(t2));
                    if (it < 256) gmlp2_unit(P, l, it, lds, t2);
                    else if (it < 512) pool2_unit(P, l, it - 256, lds, t2);
                    else if (it < 768) rglru2_unit(P, l, it - 512, lds, t2);
                    else hgrn2_unit<0>(P, l, it - 768, lds, t2);
                }
            }
            GSYNC();
            {   TIDS
                if (gtid < 65536) { const int bh = gtid >> 12, e = gtid & 4095, d = e & 63; float s = 0.f;
                    const float* stp = (const float*)(ws + WS_ST) + (size_t)bh * 64 * 4096 + e; bf16_t* sbp = (bf16_t*)(ws + WS_STB) + (size_t)bh * 64 * 4096 + e; const float* dc = (const float*)(ws + WS_DEC) + bh * 64 * 64 + d;
#pragma unroll 1
                    for (int c0 = 0; c0 < 64; c0 += 16) { float kk[16], dd[16];
#pragma unroll
                        for (int j = 0; j < 16; ++j) { kk[j] = stp[(size_t)(c0 + j) * 4096]; dd[j] = dc[(c0 + j) * 64]; }
                        __builtin_amdgcn_sched_barrier(0);
#pragma unroll
                        for (int j = 0; j < 16; ++j) { sbp[(size_t)(c0 + j) * 4096] = (bf16_t)f2bf(s); s = dd[j] * s + kk[j]; } }
                } else if (gtid < 65536 + 1024) { const int q = gtid - 65536, b = q >> 8, c = q & 255; float carry = 0.f;
                    const float* ra = (const float*)(ws + WS_RGA) + (size_t)b * 64 * 256 + c; const float* rh = (const float*)(ws + WS_RGH) + (size_t)b * 64 * 256 + c; float* cr = (float*)(ws + WS_CARRY) + (size_t)b * 64 * 256 + c;
#pragma unroll 1
                    for (int k0 = 0; k0 < 64; k0 += 16) { float aa[16], hh[16];
#pragma unroll
                        for (int j = 0; j < 16; ++j) { aa[j] = ra[(k0 + j) * 256]; hh[j] = rh[(k0 + j) * 256]; }
                        __builtin_amdgcn_sched_barrier(0);
#pragma unroll
                        for (int j = 0; j < 16; ++j) { cr[(k0 + j) * 256] = carry; carry = aa[j] * carry + hh[j]; } }
                }
            }
            GSYNC();
            {   TIDS
                const v4u* HL = (const v4u*)(ws + WS_HL); const v4u* CA = (const v4u*)(ws + WS_CA); const float* cr = (const float*)(ws + WS_CARRY);
                for (int i0 = gtid; i0 < MROWS * 32; i0 += 2 * NTHR) {
                    const int i1 = i0 + NTHR; const bool v1 = i1 < MROWS * 32; const int ix = v1 ? i1 : i0;
                    const int rowa = i0 >> 5, c0a = (i0 & 31) * 8, rowb = ix >> 5, c0b = (ix & 31) * 8;
                    const v4u hla = HL[i0], caa = CA[i0], hlb = HL[ix], cab = CA[ix];
                    const f32x4* cpa = (const f32x4*)(cr + ((size_t)(rowa >> 12) * 64 + ((rowa & 4095) >> 6)) * 256 + c0a); const f32x4* cpb = (const f32x4*)(cr + ((size_t)(rowb >> 12) * 64 + ((rowb & 4095) >> 6)) * 256 + c0b);
                    const f32x4 a0 = cpa[0], a1 = cpa[1], b0 = cpb[0], b1 = cpb[1];
                    __builtin_amdgcn_sched_barrier(0);
                    { v4u w; w.x = pk2(bflo(hla.x) + bflo(caa.x) * a0.x, bfhi(hla.x) + bfhi(caa.x) * a0.y); w.y = pk2(bflo(hla.y) + bflo(caa.y) * a0.z, bfhi(hla.y) + bfhi(caa.y) * a0.w);
                      w.z = pk2(bflo(hla.z) + bflo(caa.z) * a1.x, bfhi(hla.z) + bfhi(caa.z) * a1.y); w.w = pk2(bflo(hla.w) + bflo(caa.w) * a1.z, bfhi(hla.w) + bfhi(caa.w) * a1.w);
                      *(v4u*)(MIX + (size_t)rowa * DM + 256 + c0a) = w; }
                    if (v1) { v4u w; w.x = pk2(bflo(hlb.x) + bflo(cab.x) * b0.x, bfhi(hlb.x) + bfhi(cab.x) * b0.y); w.y = pk2(bflo(hlb.y) + bflo(cab.y) * b0.z, bfhi(hlb.y) + bfhi(cab.y) * b0.w);
                      w.z = pk2(bflo(hlb.z) + bflo(cab.z) * b1.x, bfhi(hlb.z) + bfhi(cab.z) * b1.y); w.w = pk2(bflo(hlb.w) + bflo(cab.w) * b1.z, bfhi(hlb.w) + bfhi(cab.w) * b1.w);
                      *(v4u*)(MIX + (size_t)rowb * DM + 256 + c0b) = w; }
                }
                for (int it = bid; it < 512; it += G) { int t2 = tid; asm volatile("" : "+v"(t2)); hgrn2_unit<1>(P, l, it, lds, t2); }
            }
            GSYNC();
            }
            GEMM(MIX, WOUT, DM, DM, 1, nullptr, 0, nullptr, SSl + MROWS * 16, XBc, XBn);
            GSYNC();
            for (int r_ = 0; r_ < REP_UP; ++r_) {
                pg8::Gemm g{XBc, WUP, 68 * 256, 2 * DFF, DM, 1}; pg8::Epi<3> E{ACT, DFF, nullptr, PEb, SSl + MROWS * 16, nullptr, nullptr, P.in[22] + (size_t)l * 3 * 2 * DFF, P.in[23] + (size_t)l * 2 * DFF, (PG8_LAS float*)(lds + 131072)};
                pg8::StaticOrder S; S.init(68 * 256, 2 * DFF, G, bid); pg8::gemm_phase<pg8::Epi<3>, pg8::StaticOrder, true, true>(lds, g, S, E); }
            GSYNC();
            GEMM(ACT, WDN, DM, DFF, 1, nullptr, 0, nullptr, SSl + 2 * MROWS * 16, XBc, XBc);
            GSYNC();
            GEMM(XBc, WPG, DM, DM, 2, nullptr, 0, SSl + 2 * MROWS * 16, SSl + 3 * MROWS * 16, XBn, XBc);
            GSYNC();
        }
    }
    TIDS
    for (int m = gw; m < MROWS; m += NGW) {
        f32x4* xr = (f32x4*)(X + (size_t)m * DM) + lane; const v2u* xb = (const v2u*)(XB1 + (size_t)m * DM) + lane;
        float t = SS[((size_t)12 * MROWS + m) * 16 + (lane & 15)]; t += __shfl_xor(t, 1); t += __shfl_xor(t, 2); t += __shfl_xor(t, 4); t += __shfl_xor(t, 8); const float rs = rsqrtf(t * (1.f / DM) + EPS);
#pragma unroll
        for (int j = 0; j < 4; ++j) { const f32x4 g4 = ((const f32x4*)P.in[28])[lane + 64 * j]; const v2u w = xb[64 * j]; const f32x4 xv = {bflo(w.x), bfhi(w.x), bflo(w.y), bfhi(w.y)}; xr[64 * j] = xv * rs * g4; }
    }
}

extern "C" void kernel_launch(void* const* d_in, const int* in_sizes, int n_in, void* d_out, int out_size, void* d_ws, size_t ws_size, hipStream_t stream) {
    static int grid = 0;
    if (grid == 0) {
        if (n_in != 29 || out_size != MROWS * DM || ws_size < WS_END) { fprintf(stderr, "kernel_launch: unexpected shapes: n_in %d out %d ws %zu (need %zu)\n", n_in, out_size, ws_size, (size_t)WS_END); grid = -1; return; }
        int dev = 0, cus = 0, per_cu = 0;
        hipGetDevice(&dev); hipDeviceGetAttribute(&cus, hipDeviceAttributeMultiprocessorCount, dev);
        if (hipFuncSetAttribute((const void*)mega_fwd, hipFuncAttributeMaxDynamicSharedMemorySize, LDS_BYTES) != hipSuccess) { fprintf(stderr, "kernel_launch: hipFuncSetAttribute failed\n"); grid = -1; return; }
        if (hipOccupancyMaxActiveBlocksPerMultiprocessor(&per_cu, (const void*)mega_fwd, NT, LDS_BYTES) != hipSuccess || per_cu < 1) { fprintf(stderr, "kernel_launch: occupancy query failed (%d)\n", per_cu); (void)hipGetLastError(); per_cu = 1; }
        grid = cus * 1;
    }
    if (grid < 0) return;
    if (hipMemsetAsync(d_ws, 0, 65536, stream) != hipSuccess) { fprintf(stderr, "kernel_launch: memset failed\n"); return; }
    Params p{};
    for (int i = 0; i < 29; ++i) p.in[i] = (const float*)d_in[i];
    p.out = (float*)d_out; p.ws = (unsigned char*)d_ws;
    void* args[] = {&p};
    hipError_t e = hipLaunchCooperativeKernel((const void*)mega_fwd, dim3(grid), dim3(NT), args, LDS_BYTES, stream);
    if (e != hipSuccess) fprintf(stderr, "cooperative launch failed: %s (grid %d)\n", hipGetErrorString(e), grid);
}
```
